# Optimizing an MI355X kernel written in HIP

```python
import math
import jax, jax.numpy as jnp
from jax import lax
import numpy as np

D_MODEL = 2048
BATCH = 2
SEQ = 4096
DEPTH = 2

N_META = 16
CHUNK = 128
SUB = 16
EPS = 1e-6

RET_HEADS = 8
RET_DK = 128
RET_DV = 256
RET_QK = RET_HEADS * RET_DK
RET_W = RET_HEADS * RET_DV
ROPE_BASE = 10000.0

S5_W = 1024
S5_GH = 16
S5_G = S5_W // S5_GH
S5_P = 64
DT_MIN = 1e-3
DT_MAX = 1e-1

GLA_HEADS = 4
GLA_DK = 256
GLA_DV = 512
GLA_QK = GLA_HEADS * GLA_DK
GLA_W = GLA_HEADS * GLA_DV
GLA_RANK = 16
GLA_TAU = 16.0

IN_AB = 2 * RET_QK + 2 * RET_W + 2 * S5_W
OUT_AB = RET_W + S5_W
IN_C = 2 * GLA_QK + 2 * GLA_W + GLA_RANK
N_EVEN = (DEPTH + 1) // 2
N_ODD = DEPTH // 2

kernel_name = "hybrid_retention_s5_gla_meta"


def _rmsnorm(x, w):
    xf = x.astype(jnp.float32)
    y = xf * lax.rsqrt(jnp.mean(xf * xf, axis=-1, keepdims=True) + EPS)
    return (y * w.astype(jnp.float32)).astype(x.dtype)


def _head_rmsnorm(o, w):
    y = o * lax.rsqrt(jnp.mean(o * o, axis=-1, keepdims=True) + EPS)
    b, l, hh, d = o.shape
    return y.reshape(b, l, hh * d) * w.astype(jnp.float32)


def _rope(t, cos, sin):
    half = t.shape[-1] // 2
    t1, t2 = t[..., :half], t[..., half:]
    c, s = cos[None, :, None, :], sin[None, :, None, :]
    return jnp.concatenate([t1 * c - t2 * s, t1 * s + t2 * c], axis=-1)


def _to_chunks(t):
    t = jnp.pad(t, ((0, 0), (CHUNK - N_META, 0), (0, 0), (0, 0)))
    b, lp, hh, d = t.shape
    return t.reshape(b, lp // CHUNK, CHUNK, hh, d).transpose(0, 3, 1, 2, 4)


def _from_chunks(t):
    b, hh, n, c, d = t.shape
    return t.transpose(0, 2, 3, 1, 4).reshape(b, n * c, hh, d)[:, CHUNK - N_META:]


def _retention(q, k, v):
    qc, kc, vc = _to_chunks(q), _to_chunks(k), _to_chunks(v)
    bsz = qc.shape[0]
    log_g = jnp.log1p(-jnp.exp2(-5.0 - jnp.arange(RET_HEADS, dtype=jnp.float32)))
    idx = jnp.arange(CHUNK, dtype=jnp.float32)
    diff = idx[:, None] - idx[None, :]
    causal = diff >= 0
    decay = jnp.where(causal, jnp.exp(log_g[:, None, None] * jnp.maximum(diff, 0.0)), 0.0)
    scores = jnp.einsum('bhnid,bhnjd->bhnij', qc, kc) * decay[None, :, None]
    o_intra = jnp.einsum('bhnij,bhnjv->bhniv', scores, vc)
    k_w = kc * jnp.exp(log_g[:, None] * (CHUNK - 1 - idx))[None, :, None, :, None]
    kv = jnp.einsum('bhnjd,bhnjv->nbhdv', k_w, vc)
    g_chunk = jnp.exp(log_g * CHUNK)[None, :, None, None]

    def step(s, kv_n):
        return s * g_chunk + kv_n, s

    s0 = jnp.zeros((bsz, RET_HEADS, RET_DK, RET_DV), jnp.float32)
    _, s_prev = lax.scan(step, s0, kv)
    q_w = qc * jnp.exp(log_g[:, None] * (idx + 1.0))[None, :, None, :, None]
    o_inter = jnp.einsum('bhnid,nbhdv->bhniv', q_w, s_prev)
    return _from_chunks(o_intra + o_inter)


def _s5(u, lam_re, lam_im, log_dt, b_re, b_im, c_re, c_im, d, w_glu):
    bsz, L, _ = u.shape
    lam_re = lam_re.astype(jnp.float32); lam_im = lam_im.astype(jnp.float32)
    dt = jnp.exp(log_dt.astype(jnp.float32))[:, None]
    mag = jnp.exp(lam_re * dt)
    ab_re, ab_im = mag * jnp.cos(lam_im * dt), mag * jnp.sin(lam_im * dt)
    den = lam_re * lam_re + lam_im * lam_im
    nr, ni = ab_re - 1.0, ab_im
    f_re = (nr * lam_re + ni * lam_im) / den
    f_im = (ni * lam_re - nr * lam_im) / den
    b_re = b_re.astype(jnp.float32); b_im = b_im.astype(jnp.float32)
    bb_re = f_re[..., None] * b_re - f_im[..., None] * b_im
    bb_im = f_re[..., None] * b_im + f_im[..., None] * b_re
    ug = u.reshape(bsz, L, S5_G, S5_GH)
    bu_re = jnp.einsum('blgh,gph->lbgp', ug, bb_re)
    bu_im = jnp.einsum('blgh,gph->lbgp', ug, bb_im)
    a_re = jnp.broadcast_to(ab_re, bu_re.shape)
    a_im = jnp.broadcast_to(ab_im, bu_im.shape)

    def combine(e1, e2):
        a1r, a1i, b1r, b1i = e1
        a2r, a2i, b2r, b2i = e2
        return (a2r * a1r - a2i * a1i,
                a2r * a1i + a2i * a1r,
                a2r * b1r - a2i * b1i + b2r,
                a2r * b1i + a2i * b1r + b2i)

    _, _, x_re, x_im = lax.associative_scan(combine, (a_re, a_im, bu_re, bu_im), axis=0)
    y = (jnp.einsum('lbgp,ghp->blgh', x_re, c_re.astype(jnp.float32))
         - jnp.einsum('lbgp,ghp->blgh', x_im, c_im.astype(jnp.float32)))
    y = y.reshape(bsz, L, S5_W) + d.astype(jnp.float32) * u
    y = jax.nn.gelu(y)
    return y * jax.nn.sigmoid(y @ w_glu.astype(jnp.float32))


def _gla(q, k, v, log_a):
    qc, kc, vc, gc = _to_chunks(q), _to_chunks(k), _to_chunks(v), _to_chunks(log_a)
    bsz, hh, n, c, dk = qc.shape
    dv = vc.shape[-1]
    nsub = CHUNK // SUB
    b = jnp.cumsum(gc, axis=3)
    b_last = b[:, :, :, -1]
    kv = jnp.einsum('bhnjd,bhnjv->nbhdv', kc * jnp.exp(b_last[:, :, :, None] - b), vc)
    dec = jnp.exp(b_last).transpose(2, 0, 1, 3)

    def step(s, inp):
        kv_n, dec_n = inp
        return s * dec_n[..., None] + kv_n, s

    s0 = jnp.zeros((bsz, hh, dk, dv), jnp.float32)
    _, s_prev = lax.scan(step, s0, (kv, dec))
    o_inter = jnp.einsum('bhnid,nbhdv->bhniv', qc * jnp.exp(b), s_prev)
    bs = b.reshape(bsz, hh, n, nsub, SUB, dk)
    qs = qc.reshape(bsz, hh, n, nsub, SUB, dk)
    ks = kc.reshape(bsz, hh, n, nsub, SUB, dk)
    vs = vc.reshape(bsz, hh, n, nsub, SUB, dv)
    b_ref = jnp.concatenate([jnp.zeros_like(bs[:, :, :, :1, 0]), bs[:, :, :, :-1, -1]], axis=3)
    q_hat = qs * jnp.exp(bs - b_ref[:, :, :, :, None])
    j_pos = jnp.arange(CHUNK)
    before = j_pos[None, :] < (jnp.arange(nsub) * SUB)[:, None]
    expo = jnp.where(before[:, :, None], b_ref[:, :, :, :, None] - b[:, :, :, None], -jnp.inf)
    k_hat = kc[:, :, :, None] * jnp.exp(expo)
    s_cross = jnp.einsum('bhnsid,bhnsjd->bhnsij', q_hat, k_hat)
    o_cross = jnp.einsum('bhnsij,bhnjv->bhnsiv', s_cross, vc)
    tri = jnp.arange(SUB)[:, None] >= jnp.arange(SUB)[None, :]
    expo_d = jnp.where(tri[:, :, None], bs[:, :, :, :, :, None] - bs[:, :, :, :, None], -jnp.inf)
    s_diag = jnp.einsum('bhnsid,bhnsjd,bhnsijd->bhnsij', qs, ks, jnp.exp(expo_d))
    o_diag = jnp.einsum('bhnsij,bhnsjv->bhnsiv', s_diag, vs)
    o_intra = (o_cross + o_diag).reshape(bsz, hh, n, c, dv)
    return _from_chunks(o_intra + o_inter)


def _mixer_ab(h, w_in, ret_norm_w, lam_re, lam_im, log_dt, b_re, b_im, c_re, c_im, d, w_glu, w_out, cos, sin):
    bsz, L, _ = h.shape
    proj = (h @ w_in).astype(jnp.float32)
    q, k, v, z_a, u, z_b = jnp.split(
        proj, [RET_QK, 2 * RET_QK, 2 * RET_QK + RET_W, 2 * RET_QK + 2 * RET_W,
               2 * RET_QK + 2 * RET_W + S5_W], axis=-1)
    q = _rope(q.reshape(bsz, L, RET_HEADS, RET_DK), cos, sin)
    k = _rope(k.reshape(bsz, L, RET_HEADS, RET_DK), cos, sin) * (RET_DK ** -0.5)
    v = v.reshape(bsz, L, RET_HEADS, RET_DV)
    o_a = _head_rmsnorm(_retention(q, k, v), ret_norm_w) * jax.nn.silu(z_a)
    o_b = _s5(u, lam_re, lam_im, log_dt, b_re, b_im, c_re, c_im, d, w_glu) * jax.nn.silu(z_b)
    return jnp.concatenate([o_a, o_b], axis=-1).astype(h.dtype) @ w_out


def _mixer_c(h, w_in, w_gate, b_gate, norm_w, w_out):
    bsz, L, _ = h.shape
    proj = (h @ w_in).astype(jnp.float32)
    q, k, v, z, g_low = jnp.split(
        proj, [GLA_QK, 2 * GLA_QK, 2 * GLA_QK + GLA_W, 2 * GLA_QK + 2 * GLA_W], axis=-1)
    log_a = jax.nn.log_sigmoid(g_low @ w_gate.astype(jnp.float32) + b_gate.astype(jnp.float32)) / GLA_TAU
    o = _gla(q.reshape(bsz, L, GLA_HEADS, GLA_DK) * (GLA_DK ** -0.5),
             k.reshape(bsz, L, GLA_HEADS, GLA_DK),
             v.reshape(bsz, L, GLA_HEADS, GLA_DV),
             log_a.reshape(bsz, L, GLA_HEADS, GLA_DK))
    o = _head_rmsnorm(o, norm_w) * jax.nn.silu(z)
    return o.astype(h.dtype) @ w_out


def setup_inputs(seed: int = 0) -> dict:
    key = jax.random.key(seed)
    ks = jax.random.split(key, 24)
    f32 = jnp.float32

    def nrm(k, shape, scale):
        return jax.random.normal(k, shape, f32) * scale

    return {
        "x": nrm(ks[0], (BATCH, SEQ, D_MODEL), 1.0),
        "meta": nrm(ks[1], (N_META, D_MODEL), 1.0),
        "norm_ab_w": 1.0 + nrm(ks[2], (N_EVEN, D_MODEL), 0.02),
        "w_in_ab": nrm(ks[3], (N_EVEN, D_MODEL, IN_AB), D_MODEL ** -0.5),
        "ret_norm_w": 1.0 + nrm(ks[4], (N_EVEN, RET_W), 0.02),
        "s5_lam_re": -0.5 + nrm(ks[5], (N_EVEN, S5_G, S5_P), 0.01),
        "s5_lam_im": math.pi * jnp.arange(S5_P, dtype=f32) + nrm(ks[6], (N_EVEN, S5_G, S5_P), 0.01),
        "s5_log_dt": jax.random.uniform(ks[7], (N_EVEN, S5_G), f32, math.log(DT_MIN), math.log(DT_MAX)),
        "s5_b_re": nrm(ks[8], (N_EVEN, S5_G, S5_P, S5_GH), (2 * S5_GH) ** -0.5),
        "s5_b_im": nrm(ks[9], (N_EVEN, S5_G, S5_P, S5_GH), (2 * S5_GH) ** -0.5),
        "s5_c_re": nrm(ks[10], (N_EVEN, S5_G, S5_GH, S5_P), S5_P ** -0.5),
        "s5_c_im": nrm(ks[11], (N_EVEN, S5_G, S5_GH, S5_P), S5_P ** -0.5),
        "s5_d": nrm(ks[12], (N_EVEN, S5_W), 1.0),
        "s5_w_glu": nrm(ks[13], (N_EVEN, S5_W, S5_W), S5_W ** -0.5),
        "w_out_ab": nrm(ks[14], (N_EVEN, OUT_AB, D_MODEL), OUT_AB ** -0.5),
        "norm_c_w": 1.0 + nrm(ks[15], (N_ODD, D_MODEL), 0.02),
        "w_in_c": nrm(ks[16], (N_ODD, D_MODEL, IN_C), D_MODEL ** -0.5),
        "gla_w_gate": nrm(ks[17], (N_ODD, GLA_RANK, GLA_QK), GLA_RANK ** -0.5),
        "gla_b_gate": nrm(ks[18], (N_ODD, GLA_QK), 0.1),
        "gla_norm_w": 1.0 + nrm(ks[19], (N_ODD, GLA_W), 0.02),
        "w_out_c": nrm(ks[20], (N_ODD, GLA_W, D_MODEL), GLA_W ** -0.5),
        "final_norm_w": 1.0 + nrm(ks[21], (D_MODEL,), 0.02),
    }


def reference(x, meta, norm_ab_w, w_in_ab, ret_norm_w, s5_lam_re, s5_lam_im, s5_log_dt,
              s5_b_re, s5_b_im, s5_c_re, s5_c_im, s5_d, s5_w_glu, w_out_ab,
              norm_c_w, w_in_c, gla_w_gate, gla_b_gate, gla_norm_w, w_out_c, final_norm_w):
    bsz = x.shape[0]
    h = jnp.concatenate(
        [jnp.broadcast_to(meta.astype(x.dtype)[None], (bsz, N_META, D_MODEL)), x], axis=1)
    L = h.shape[1]
    pos = jnp.arange(L, dtype=jnp.float32)
    inv_freq = jnp.power(ROPE_BASE, -jnp.arange(0, RET_DK, 2, dtype=jnp.float32) / RET_DK)
    ang = pos[:, None] * inv_freq[None, :]
    cos, sin = jnp.cos(ang), jnp.sin(ang)
    for layer in range(DEPTH):
        i = layer // 2
        if layer % 2 == 0:
            h = h + _mixer_ab(_rmsnorm(h, norm_ab_w[i]), w_in_ab[i], ret_norm_w[i],
                              s5_lam_re[i], s5_lam_im[i], s5_log_dt[i], s5_b_re[i], s5_b_im[i],
                              s5_c_re[i], s5_c_im[i], s5_d[i], s5_w_glu[i], w_out_ab[i], cos, sin)
        else:
            h = h + _mixer_c(_rmsnorm(h, norm_c_w[i]), w_in_c[i], gla_w_gate[i], gla_b_gate[i],
                             gla_norm_w[i], w_out_c[i])
    return _rmsnorm(h, final_norm_w)[:, N_META:]
```

```cpp
#define RUN_PH NPHASE
#define DBG_INTER 1
#define DBG_NORM 1
#include <hip/hip_runtime.h>
#include <hip/hip_cooperative_groups.h>
#include <cstdio>
#include <cstdint>
namespace cg = cooperative_groups;

#define LAS __attribute__((address_space(3)))
typedef unsigned short bf16_t;
typedef short bf16x8 __attribute__((ext_vector_type(8)));
typedef float f32x4 __attribute__((ext_vector_type(4)));
typedef float f32x2 __attribute__((ext_vector_type(2)));
typedef unsigned u32x4 __attribute__((ext_vector_type(4)));
typedef unsigned u32x2 __attribute__((ext_vector_type(2)));

constexpr int DM = 2048, SEQ = 4096, LP = 4224, NR = 2 * LP, NCH = 33, PADR = 112;
constexpr float EPS = 1e-6f;
constexpr size_t SLOT = (size_t)NR * 1024 * 2;
constexpr size_t MISC = 15 * SLOT;
constexpr size_t M_CTR = 0, M_SSQ1 = 1024, M_SSQ2 = 34816, M_ROPE = 131072, M_S5AB = 2359296, M_S5A128 = M_S5AB + 32768,
                 M_S5BB = 2424832, M_S5C = 2949120, M_S5E = 3211264, M_DEC1 = 5373952, M_GLOW = 5644288;
constexpr int LDS_BYTES = 147456;
constexpr int NPHASE = 12;

struct Ctx {
    const float *x, *meta, *norm_ab_w, *w_in_ab, *ret_norm_w, *lam_re, *lam_im, *log_dt, *b_re, *b_im, *c_re, *c_im, *s5d, *w_glu, *w_out_ab,
        *norm_c_w, *w_in_c, *w_gate, *b_gate, *gla_norm_w, *w_out_c, *final_w;
    float* out; unsigned char* ws; int ph_lo, ph_hi;
};

#define WSB(off) (C.ws + (off))
#define SL(i) ((bf16_t*)(C.ws + (size_t)(i) * SLOT))
#define W1T SL(0)
#define WO1T SL(2)
#define U0 SL(3)
#define Q0RAW SL(4)
#define K0RAW SL(5)
#define V0RAW SL(6)
#define ZA0 SL(8)
#define ZB0 SL(10)
#define WGLUT SL(11)
#define WO2T ((bf16_t*)(C.ws + 11 * SLOT + 2097152))
#define KD0 SL(12)
#define KT0 SL(13)
#define YG SL(14)
#define A0 ((bf16_t*)C.out)
#define VT0 ((bf16_t*)C.out)
#define QD0 ((bf16_t*)((unsigned char*)C.out + 2 * SLOT))
#define SP0 SL(0)
#define YCAT SL(3)
#define W3T SL(6)
#define A1 SL(0)
#define Q1RAW SL(3)
#define K1RAW SL(4)
#define V1RAW SL(8)
#define Z1 SL(12)
#define QD1 SL(5)
#define KD1 SL(10)
#define KT1 SL(14)
#define VT1 SL(0)
#define SP1 SL(6)
#define Y1 SL(3)
#define CTR ((unsigned*)WSB(MISC + M_CTR))
#define SSQ1 ((float*)WSB(MISC + M_SSQ1))
#define SSQ2 ((float*)WSB(MISC + M_SSQ2))
#define ROPE ((f32x2*)WSB(MISC + M_ROPE))
#define S5AB ((f32x2*)WSB(MISC + M_S5AB))
#define S5A128 ((f32x2*)WSB(MISC + M_S5A128))
#define S5BB ((float*)WSB(MISC + M_S5BB))
#define S5C ((bf16_t*)WSB(MISC + M_S5C))
#define S5E ((float*)WSB(MISC + M_S5E))
#define DEC1 ((float*)WSB(MISC + M_DEC1))
#define GLOW ((float*)WSB(MISC + M_GLOW))

#define LDS_FENCE() asm volatile("s_waitcnt lgkmcnt(0)" ::: "memory")
typedef __bf16 bf16v2_t __attribute__((ext_vector_type(2)));
__device__ __forceinline__ unsigned cvt_pk_bf16(float lo, float hi) { bf16v2_t v; v.x = (__bf16)lo; v.y = (__bf16)hi; return __builtin_bit_cast(unsigned, v); }
__device__ __forceinline__ bf16_t f2bf(float f) { return (bf16_t)(cvt_pk_bf16(f, 0.f) & 0xffffu); }
__device__ __forceinline__ float bf2f(bf16_t h) { return __uint_as_float(((unsigned)h) << 16); }
__device__ __forceinline__ float bflo(unsigned w) { return __uint_as_float(w << 16); }
__device__ __forceinline__ float bfhi(unsigned w) { return __uint_as_float(w & 0xffff0000u); }
__device__ __forceinline__ float wave_sum(float v) {
#pragma unroll
    for (int o = 1; o < 64; o <<= 1) v += __shfl_xor(v, o);
    return v;
}
__device__ __forceinline__ float sigmoidf_(float x) { return 1.f / (1.f + __expf(-x)); }
__device__ __forceinline__ float siluf_(float x) { return x / (1.f + __expf(-x)); }
__device__ __forceinline__ float gelu_tanh(float x) { const float t = 0.7978845608028654f * (x + 0.044715f * x * x * x); const float th = 1.f - 2.f / (__expf(2.f * t) + 1.f); return 0.5f * x * (1.f + th); }
__device__ __forceinline__ f32x4 mfma16(bf16x8 a, bf16x8 b, f32x4 c) { return __builtin_amdgcn_mfma_f32_16x16x32_bf16(a, b, c, 0, 0, 0); }
__device__ __forceinline__ int wave_fetch(unsigned* ctr, int lane) { unsigned v = 0; if (lane == 0) v = atomicAdd(ctr, 1u); return (int)__builtin_amdgcn_readfirstlane(v); }
__device__ __forceinline__ void dsincos(double x, double& s, double& c) {
    const double q = rint(x * 0.6366197723675814);
    double r = fma(-q, 1.5707963267948966, x); r = fma(-q, 6.123233995736766e-17, r);
    const int iq = ((int)q) & 3; const double r2 = r * r;
    const double sp = r * (1.0 + r2 * (-1.0 / 6 + r2 * (1.0 / 120 + r2 * (-1.0 / 5040 + r2 * (1.0 / 362880 + r2 * (-1.0 / 39916800 + r2 * (1.0 / 6227020800.0)))))));
    const double cp = 1.0 + r2 * (-0.5 + r2 * (1.0 / 24 + r2 * (-1.0 / 720 + r2 * (1.0 / 40320 + r2 * (-1.0 / 3628800 + r2 * (1.0 / 479001600.0 + r2 * (-1.0 / 87178291200.0)))))));
    s = (iq == 0) ? sp : (iq == 1) ? cp : (iq == 2) ? -sp : -cp;
    c = (iq == 0) ? cp : (iq == 1) ? -sp : (iq == 2) ? -cp : sp;
}

namespace pg8 {
constexpr int BM = 256, BK = 64, HALF = 128, HTB = HALF * BK * 2, STAGE_BYTES = 8 * HTB, NXCD = 8, WGM = 8;
__host__ __device__ __forceinline__ int lds_byte(int r, int c) { const int st = (r >> 4) * 2 + (c >> 5), rr = r & 15, cc = c & 31, ob = rr * 64 + cc * 2; return st * 1024 + (ob ^ (((ob >> 9) & 1) << 5)); }
__host__ __device__ __forceinline__ void stage_rc(int b, int& R, int& Cc) { const int st = b / 1024, sb = b % 1024, swz = sb ^ (((sb >> 9) & 1) << 5); R = (st >> 1) * 16 + swz / 64; Cc = (st & 1) * 32 + (swz % 64) / 2; }
__host__ __device__ __forceinline__ int perm32(int rho) { const int n = rho >> 4, i = rho & 15; return 8 * (i >> 2) + 4 * n + (i & 3); }
struct Unit { int pm, pn; };
struct Gemm { const bf16_t* A; const bf16_t* Bt; int lda, ldb, K; };
__device__ __forceinline__ int arow(int pm) { return (pm >> 4) * LP + 128 + (pm & 15) * 256; }
struct StaticOrder {
    int nM, nN, nwg, G, c;
    __device__ void init(int M, int N, int G_, int c_) { nM = M / BM; nN = N / BM; nwg = nM * nN; G = G_; c = c_; }
    __device__ bool next(int i, Unit& u) const {
        const long L = (long)i * G + c; if (L >= nwg) return false;
        int wgid = (int)L; { const int q = nwg / NXCD, r = nwg % NXCD, xcd = wgid % NXCD, off = wgid / NXCD; wgid = (xcd < r ? xcd * (q + 1) : r * (q + 1) + (xcd - r) * q) + off; }
        const int nig = WGM * nN, gid = wgid / nig, fm = gid * WGM, gsz = (nM - fm) < WGM ? (nM - fm) : WGM;
        u.pm = fm + ((wgid % nig) % gsz); u.pn = (wgid % nig) / gsz; return true;
    }
};
struct SubOrder {
    int nN, c, nunits;
    __device__ bool next(int i, Unit& u) const { if (i > 0 || c >= nunits) return false; u.pm = c / nN; u.pn = c % nN; return true; }
};

template <class Epi, class Sched>
__device__ __forceinline__ void gemm_phase(LAS unsigned char* lds, const Gemm g, const Sched& S, const Epi& E) {
    const int tid = threadIdx.x, wid = __builtin_amdgcn_readfirstlane(tid >> 6), lane = tid & 63, wr = wid >> 2, wc = wid & 3, fr = lane & 15, fq = lane >> 4;
    const int K = g.K, nt = K / BK;
    unsigned voffA[2], voffB[2];
#pragma unroll
    for (int i = 0; i < 2; ++i) { int R, Cc; stage_rc(tid * 16 + i * 8192, R, Cc); const int Rb = (R & ~31) + perm32(R & 31);
        voffA[i] = (unsigned)(R * g.lda + Cc) * 2u; voffB[i] = (unsigned)(Rb * g.ldb + Cc) * 2u; }
    const size_t kstep = (size_t)(BK * 2);
    const size_t hA = (size_t)HALF * g.lda * 2, hB = (size_t)HALF * g.ldb * 2;
    const unsigned ldsw = (unsigned)wid * 1024u;
    const int aoff = lds_byte(wr * 64 + fr, fq * 8), boff = lds_byte(wc * 32 + fr, fq * 8);
#define PG8_SA(b, h) (((b) * 2 + (h)) * HTB)
#define PG8_SB(b, h) ((4 + (b) * 2 + (h)) * HTB)
#define PG8_STAGE(bufoff, gbase, voff) do { _Pragma("unroll") for (int _i = 0; _i < 2; ++_i) \
        __builtin_amdgcn_global_load_lds((const unsigned*)((const char*)(gbase) + (voff)[_i]), (LAS unsigned*)(lds + (bufoff) + ldsw + _i * 8192), 16, 0, 0); } while (0)
#define PG8_LDA(dst, b, h) do { _Pragma("unroll") for (int m = 0; m < 4; ++m) _Pragma("unroll") for (int k = 0; k < 2; ++k) dst[m][k] = *(const LAS bf16x8*)(lds + PG8_SA(b, h) + aoff + m * 2048 + k * 1024); } while (0)
#define PG8_LDB(dst, b, h) do { _Pragma("unroll") for (int n = 0; n < 2; ++n) _Pragma("unroll") for (int k = 0; k < 2; ++k) dst[n][k] = *(const LAS bf16x8*)(lds + PG8_SB(b, h) + boff + n * 2048 + k * 1024); } while (0)
#define PG8_MMA(ai, bj, At, Bt) do { __builtin_amdgcn_s_setprio(1); _Pragma("unroll") for (int m = 0; m < 4; ++m) _Pragma("unroll") for (int n = 0; n < 2; ++n) _Pragma("unroll") for (int k = 0; k < 2; ++k) \
        acc[ai][bj][m][n] = __builtin_amdgcn_mfma_f32_16x16x32_bf16(Bt[n][k], At[m][k], acc[ai][bj][m][n], 0, 0, 0); __builtin_amdgcn_s_setprio(0); } while (0)
#define PG8_WAIT_V(n) asm volatile("s_waitcnt vmcnt(" #n ")" ::: "memory")
#define PG8_WAIT_L(n) asm volatile("s_waitcnt lgkmcnt(" #n ")" ::: "memory")
#define PG8_BAR __builtin_amdgcn_s_barrier()
#define PG8_SCHED __builtin_amdgcn_sched_barrier(0)
    Unit cur, nxt; int ui = 0;
    if (!S.next(0, cur)) return;
    f32x4 acc[2][2][4][2];
#pragma unroll
    for (int a = 0; a < 2; ++a)
#pragma unroll
        for (int b = 0; b < 2; ++b)
#pragma unroll
            for (int m = 0; m < 4; ++m)
#pragma unroll
                for (int n = 0; n < 2; ++n) acc[a][b][m][n] = (f32x4){0.f, 0.f, 0.f, 0.f};
    bf16x8 At[4][2], B0[2][2], B1[2][2];
    const char* cA = (const char*)g.A + (size_t)arow(cur.pm) * g.lda * 2; const char* cB = (const char*)g.Bt + (size_t)cur.pn * 256 * g.ldb * 2;
    PG8_STAGE(PG8_SB(0, 0), cB, voffB); PG8_STAGE(PG8_SB(0, 1), cB + hB, voffB); PG8_STAGE(PG8_SA(0, 0), cA, voffA); PG8_STAGE(PG8_SA(0, 1), cA + hA, voffA);
    if (wr == 1) PG8_BAR;
    PG8_WAIT_V(2); PG8_BAR;
    PG8_STAGE(PG8_SB(1, 0), cB + kstep, voffB); PG8_STAGE(PG8_SA(1, 0), cA + kstep, voffA); PG8_STAGE(PG8_SB(1, 1), cB + hB + kstep, voffB);
    PG8_WAIT_V(6); PG8_BAR;
    for (;;) {
        const bool has_next = S.next(ui + 1, nxt);
        const char* nA = has_next ? (const char*)g.A + (size_t)arow(nxt.pm) * g.lda * 2 : cA; const char* nB = has_next ? (const char*)g.Bt + (size_t)nxt.pn * 256 * g.ldb * 2 : cB;
        for (int t = 0; t < nt; t += 2) {
            const bool last = (t == nt - 2);
            const char* a1 = cA + (size_t)(t + 1) * kstep;
            const char* a2 = last ? nA : cA + (size_t)(t + 2) * kstep; const char* b2 = last ? nB : cB + (size_t)(t + 2) * kstep;
            const char* a3 = a2 + kstep; const char* b3 = b2 + kstep;
            PG8_LDB(B0, 0, 0); PG8_LDB(B1, 0, 1); PG8_SCHED; PG8_LDA(At, 0, 0); PG8_STAGE(PG8_SA(1, 1), a1 + hA, voffA);
            PG8_WAIT_V(8); PG8_WAIT_L(0); PG8_BAR; PG8_MMA(0, 0, At, B0); PG8_MMA(0, 1, At, B1); PG8_BAR; PG8_SCHED;
            PG8_LDA(At, 0, 1); PG8_STAGE(PG8_SB(0, 0), b2, voffB); PG8_STAGE(PG8_SB(0, 1), b2 + hB, voffB); PG8_STAGE(PG8_SA(0, 0), a2, voffA);
            PG8_WAIT_V(8); PG8_WAIT_L(0); PG8_BAR; PG8_MMA(1, 0, At, B0); PG8_MMA(1, 1, At, B1); PG8_BAR; PG8_SCHED;
            PG8_LDB(B0, 1, 0); PG8_LDB(B1, 1, 1); PG8_SCHED; PG8_LDA(At, 1, 0); PG8_STAGE(PG8_SA(0, 1), a2 + hA, voffA);
            PG8_WAIT_V(8); PG8_WAIT_L(0); PG8_BAR; PG8_MMA(0, 0, At, B0); PG8_MMA(0, 1, At, B1); PG8_BAR; PG8_SCHED;
            PG8_LDA(At, 1, 1); PG8_STAGE(PG8_SB(1, 0), b3, voffB); PG8_STAGE(PG8_SB(1, 1), b3 + hB, voffB); PG8_STAGE(PG8_SA(1, 0), a3, voffA);
            PG8_WAIT_V(8); PG8_WAIT_L(0); PG8_BAR; PG8_MMA(1, 0, At, B0); PG8_MMA(1, 1, At, B1); PG8_BAR; PG8_SCHED;
        }
        if (wr == 0) PG8_BAR;
        E(acc, cur, wr, wc, fr, fq);
        if (!has_next) break;
#pragma unroll
        for (int a = 0; a < 2; ++a)
#pragma unroll
            for (int b = 0; b < 2; ++b)
#pragma unroll
                for (int m = 0; m < 4; ++m)
#pragma unroll
                    for (int n = 0; n < 2; ++n) acc[a][b][m][n] = (f32x4){0.f, 0.f, 0.f, 0.f};
        cur = nxt; cA = nA; cB = nB; ++ui;
        if (wr == 1) PG8_BAR;
    }
    PG8_WAIT_V(0);
    PG8_BAR;
#undef PG8_SA
#undef PG8_SB
#undef PG8_STAGE
#undef PG8_LDA
#undef PG8_LDB
#undef PG8_MMA
#undef PG8_WAIT_V
#undef PG8_WAIT_L
#undef PG8_BAR
#undef PG8_SCHED
}
typedef f32x4 Acc[2][2][4][2];

__device__ __forceinline__ void route(const Ctx& C, int layer, int c0, bf16_t*& dst, int& ld, int& cc) {
    if (layer == 0) {
        if (c0 < 1024) { dst = Q0RAW; ld = 1024; cc = c0; } else if (c0 < 2048) { dst = K0RAW; ld = 1024; cc = c0 - 1024; }
        else if (c0 < 4096) { dst = V0RAW; ld = 2048; cc = c0 - 2048; } else if (c0 < 6144) { dst = ZA0; ld = 2048; cc = c0 - 4096; }
        else if (c0 < 7168) { dst = U0; ld = 1024; cc = c0 - 6144; } else { dst = ZB0; ld = 1024; cc = c0 - 7168; }
    } else {
        if (c0 < 1024) { dst = Q1RAW; ld = 1024; cc = c0; } else if (c0 < 2048) { dst = K1RAW; ld = 1024; cc = c0 - 1024; }
        else if (c0 < 4096) { dst = V1RAW; ld = 2048; cc = c0 - 2048; } else { dst = Z1; ld = 2048; cc = c0 - 4096; }
    }
}
template <int LAYER> struct EpiProj {
    Ctx C;
    __device__ __forceinline__ void operator()(const Acc& acc, const Unit& u, int wr, int wc, int fr, int fq) const {
        bf16_t* dst; int ld, c0; route(C, LAYER, u.pn * 256, dst, ld, c0);
        const int rbase = arow(u.pm);
#pragma unroll
        for (int ai = 0; ai < 2; ++ai)
#pragma unroll
            for (int m = 0; m < 4; ++m) {
                const int R = rbase + ai * 128 + wr * 64 + m * 16 + fr;
                float sc = 1.f; if (LAYER == 1) sc = rsqrtf(SSQ1[R] * (1.f / 2048.f) + EPS);
#pragma unroll
                for (int bj = 0; bj < 2; ++bj) {
                    const int cl = c0 + bj * 128 + wc * 32 + 8 * fq; const f32x4 v0 = acc[ai][bj][m][0] * sc, v1 = acc[ai][bj][m][1] * sc;
                    u32x4 w; w.x = cvt_pk_bf16(v0[0], v0[1]); w.y = cvt_pk_bf16(v0[2], v0[3]); w.z = cvt_pk_bf16(v1[0], v1[1]); w.w = cvt_pk_bf16(v1[2], v1[3]);
                    *(u32x4*)(dst + (size_t)R * ld + cl) = w;
                }
            }
    }
};
struct EpiGLU {
    Ctx C;
    __device__ __forceinline__ void operator()(const Acc& acc, const Unit& u, int wr, int wc, int fr, int fq) const {
        const int rbase = arow(u.pm), c0 = u.pn * 256;
#pragma unroll
        for (int ai = 0; ai < 2; ++ai)
#pragma unroll
            for (int m = 0; m < 4; ++m) {
                const int R = rbase + ai * 128 + wr * 64 + m * 16 + fr;
#pragma unroll
                for (int bj = 0; bj < 2; ++bj) {
                    const int cl = c0 + bj * 128 + wc * 32 + 8 * fq;
                    const u32x4 yv = *(const u32x4*)(YG + (size_t)R * 1024 + cl), zv = *(const u32x4*)(ZB0 + (size_t)R * 1024 + cl);
                    const f32x4 a0 = acc[ai][bj][m][0], a1 = acc[ai][bj][m][1];
                    float o[8];
                    o[0] = bflo(yv.x) * sigmoidf_(a0[0]) * siluf_(bflo(zv.x)); o[1] = bfhi(yv.x) * sigmoidf_(a0[1]) * siluf_(bfhi(zv.x));
                    o[2] = bflo(yv.y) * sigmoidf_(a0[2]) * siluf_(bflo(zv.y)); o[3] = bfhi(yv.y) * sigmoidf_(a0[3]) * siluf_(bfhi(zv.y));
                    o[4] = bflo(yv.z) * sigmoidf_(a1[0]) * siluf_(bflo(zv.z)); o[5] = bfhi(yv.z) * sigmoidf_(a1[1]) * siluf_(bfhi(zv.z));
                    o[6] = bflo(yv.w) * sigmoidf_(a1[2]) * siluf_(bflo(zv.w)); o[7] = bfhi(yv.w) * sigmoidf_(a1[3]) * siluf_(bfhi(zv.w));
                    u32x4 w; w.x = cvt_pk_bf16(o[0], o[1]); w.y = cvt_pk_bf16(o[2], o[3]); w.z = cvt_pk_bf16(o[4], o[5]); w.w = cvt_pk_bf16(o[6], o[7]);
                    *(u32x4*)(YCAT + (size_t)R * 3072 + 2048 + cl) = w;
                }
            }
    }
};
template <int LAYER> struct EpiOut {
    Ctx C;
    __device__ __forceinline__ void operator()(const Acc& acc, const Unit& u, int wr, int wc, int fr, int fq) const {
        const int rbase = arow(u.pm);
        const float* base = (LAYER == 0) ? C.x : C.out;
#pragma unroll
        for (int ai = 0; ai < 2; ++ai)
#pragma unroll
            for (int m = 0; m < 4; ++m) {
                const int rl = ai * 128 + wr * 64 + m * 16 + fr, R = rbase + rl, xr = u.pm * 256 + rl;
                float s = 0.f;
#pragma unroll
                for (int bj = 0; bj < 2; ++bj) {
                    const int cl = u.pn * 256 + bj * 128 + wc * 32 + 8 * fq;
                    const f32x4 h0 = *(const f32x4*)(base + (size_t)xr * DM + cl) + acc[ai][bj][m][0], h1 = *(const f32x4*)(base + (size_t)xr * DM + cl + 4) + acc[ai][bj][m][1];
                    *(f32x4*)(C.out + (size_t)xr * DM + cl) = h0; *(f32x4*)(C.out + (size_t)xr * DM + cl + 4) = h1;
                    s += (h0[0] * h0[0] + h0[1] * h0[1]) + (h0[2] * h0[2] + h0[3] * h0[3]) + (h1[0] * h1[0] + h1[1] * h1[1]) + (h1[2] * h1[2] + h1[3] * h1[3]);
                    if (LAYER == 0) {
                        const f32x4 w0 = *(const f32x4*)(C.norm_c_w + cl), w1 = *(const f32x4*)(C.norm_c_w + cl + 4);
                        u32x4 w; w.x = cvt_pk_bf16(h0[0] * w0[0], h0[1] * w0[1]); w.y = cvt_pk_bf16(h0[2] * w0[2], h0[3] * w0[3]); w.z = cvt_pk_bf16(h1[0] * w1[0], h1[1] * w1[1]); w.w = cvt_pk_bf16(h1[2] * w1[2], h1[3] * w1[3]);
                        *(u32x4*)(A1 + (size_t)R * DM + cl) = w;
                    }
                }
                s += __shfl_xor(s, 16); s += __shfl_xor(s, 32);
                if (fq == 0) atomicAdd((LAYER == 0) ? (SSQ1 + R) : (SSQ2 + xr), s);
            }
    }
};
}

__device__ __forceinline__ f32x4 skinny16(const bf16_t* Ap, int lda, const bf16_t* Bp, int ldb, int K, int lane) {
    const bf16_t* a = Ap + (size_t)(lane & 15) * lda + (lane >> 4) * 8;
    const bf16_t* b = Bp + (size_t)(lane & 15) * ldb + (lane >> 4) * 8;
    f32x4 acc = {0.f, 0.f, 0.f, 0.f};
#pragma unroll 8
    for (int k = 0; k < K; k += 32) { const bf16x8 av = *(const bf16x8*)(a + k), bv = *(const bf16x8*)(b + k); acc = mfma16(av, bv, acc); }
    return acc;
}

__device__ __forceinline__ void transpose_item(const float* W, int K, int N, bf16_t* WT, LAS float* scr, int item, int lane) {
    const int nblk = (N + 31) / 32, kb = item / nblk, nb = item % nblk, k0 = 64 * kb, n0 = 32 * nb;
    const int nn = n0 + (lane & 31);
#pragma unroll 8
    for (int i = 0; i < 32; ++i) { const int kk = 2 * i + (lane >> 5); scr[kk * 33 + (lane & 31)] = (nn < N) ? W[(size_t)(k0 + kk) * N + nn] : 0.f; }
    LDS_FENCE();
    const int c = lane & 7;
#pragma unroll
    for (int j = 0; j < 4; ++j) { const int n = (lane >> 3) + 8 * j; const LAS float* s = scr + (8 * c) * 33 + n;
        u32x4 o; o.x = cvt_pk_bf16(s[0 * 33], s[1 * 33]); o.y = cvt_pk_bf16(s[2 * 33], s[3 * 33]); o.z = cvt_pk_bf16(s[4 * 33], s[5 * 33]); o.w = cvt_pk_bf16(s[6 * 33], s[7 * 33]);
        if (n0 + n < N) *(u32x4*)(WT + (size_t)(n0 + n) * K + k0 + 8 * c) = o; }
    LDS_FENCE();
}

__device__ __forceinline__ void p0_phase(const Ctx& C, LAS unsigned char* lds, int tid, int lane, int wave, int bid, int G) {
    LAS float* scr = (LAS float*)(lds + wave * 16384);
    const int gw = wave * G + bid, NGW = G * 8;
    constexpr int I1 = (2048 / 64) * (8192 / 32), IG = (1024 / 64) * (1024 / 32), IO1 = (3072 / 64) * (2048 / 32), IO2 = (2048 / 64) * (2048 / 32);
    for (int it = gw; it < I1 + IG + IO1 + IO2; it += NGW) {
        int r = it;
        if (r < I1) { transpose_item(C.w_in_ab, 2048, 8192, W1T, scr, r, lane); continue; } r -= I1;
        if (r < IG) { transpose_item(C.w_glu, 1024, 1024, WGLUT, scr, r, lane); continue; } r -= IG;
        if (r < IO1) { transpose_item(C.w_out_ab, 3072, 2048, WO1T, scr, r, lane); continue; } r -= IO1;
        transpose_item(C.w_out_c, 2048, 2048, WO2T, scr, r, lane);
    }
    for (int idx = gw; idx < 2 * 4112; idx += NGW) {
        const int b = idx / 4112, rr = idx % 4112;
        const float* src = (rr < 16) ? (C.meta + (size_t)rr * DM) : (C.x + ((size_t)b * SEQ + (rr - 16)) * DM);
        f32x4 v[8]; float s = 0.f;
#pragma unroll
        for (int j = 0; j < 8; ++j) { v[j] = *(const f32x4*)(src + (lane + 64 * j) * 4); s += (v[j][0] * v[j][0] + v[j][1] * v[j][1]) + (v[j][2] * v[j][2] + v[j][3] * v[j][3]); }
        const float rstd = rsqrtf(wave_sum(s) * (1.f / 2048.f) + EPS);
        bf16_t* dst = A0 + (size_t)(b * LP + PADR + rr) * DM;
#pragma unroll
        for (int j = 0; j < 8; ++j) { const f32x4 w = *(const f32x4*)(C.norm_ab_w + (lane + 64 * j) * 4);
            u32x2 o; o.x = cvt_pk_bf16(v[j][0] * rstd * w[0], v[j][1] * rstd * w[1]); o.y = cvt_pk_bf16(v[j][2] * rstd * w[2], v[j][3] * rstd * w[3]);
            *(u32x2*)(dst + (lane + 64 * j) * 4) = o; }
    }
    const int gt = bid * 512 + tid, NGT = G * 512;
    for (int idx = gt; idx < 4112 * 64; idx += NGT) {
        const int pos = idx >> 6, i = idx & 63;
        const double inv = exp(-(double)i * (9.210340371976184 / 64.0)); double s, c; dsincos((double)pos * inv, s, c);
        ROPE[idx] = (f32x2){(float)c, (float)s};
    }
    for (int idx = gt; idx < 4096; idx += NGT) {
        const int g = idx >> 6;
        const double lr = C.lam_re[idx], li = C.lam_im[idx], dt = exp((double)C.log_dt[g]);
        const double mag = exp(lr * dt); double s, c; dsincos(li * dt, s, c); const double ar = mag * c, ai = mag * s;
        S5AB[idx] = (f32x2){(float)ar, (float)ai};
        double pr = ar, pi = ai;
#pragma unroll
        for (int q = 0; q < 7; ++q) { const double nr_ = pr * pr - pi * pi, ni_ = 2.0 * pr * pi; pr = nr_; pi = ni_; }
        S5A128[idx] = (f32x2){(float)pr, (float)pi};
        const double den = lr * lr + li * li, nr = ar - 1.0, ni = ai, fre = (nr * lr + ni * li) / den, fim = (ni * lr - nr * li) / den;
        for (int h = 0; h < 16; ++h) { const double br = C.b_re[idx * 16 + h], bi = C.b_im[idx * 16 + h];
            S5BB[idx * 32 + h] = (float)(fre * br - fim * bi); S5BB[idx * 32 + 16 + h] = (float)(fre * bi + fim * br); }
    }
    for (int idx = gt; idx < 65536; idx += NGT) { const int gh = idx >> 6, p = idx & 63; S5C[gh * 128 + p] = f2bf(C.c_re[idx]); S5C[gh * 128 + 64 + p] = f2bf(-C.c_im[idx]); }
    for (int idx = gt; idx < NR; idx += NGT) SSQ1[idx] = 0.f;
    for (int idx = gt; idx < 8192; idx += NGT) SSQ2[idx] = 0.f;
    if (gt < 64) CTR[gt] = 0u;
}

template <int LAYER>
__device__ __forceinline__ void prep_item(const Ctx& C, int item, int tid) {
    const int b = item / (NCH * 6), n = (item / 6) % NCH, part = item % 6, r0 = n * 128;
    const int npad8 = (n == 0) ? 14 : 0;
    if (part < 2) {
        const int c = part * 512 + tid;
        const bf16_t* qraw = LAYER == 0 ? Q0RAW : Q1RAW; const bf16_t* kraw = LAYER == 0 ? K0RAW : K1RAW;
        bf16_t* qd = LAYER == 0 ? QD0 : QD1; bf16_t* kd = LAYER == 0 ? KD0 : KD1; bf16_t* kt = LAYER == 0 ? KT0 : KT1;
        if (LAYER == 0) {
            const int h = c >> 7, d = c & 127, pc = c ^ 64;
            const float lg = (float)log1p(-exp2(-5.0 - (double)h));
            bf16_t* ktp = kt + (size_t)((b * 8 + h) * 128 + d) * LP + r0;
            for (int j8 = 0; j8 < 16; ++j8) {
                unsigned kp[4] = {0u, 0u, 0u, 0u};
                if (j8 >= npad8) {
                    float kv[8];
#pragma unroll
                    for (int jj = 0; jj < 8; ++jj) {
                        const int j = j8 * 8 + jj, r = r0 + j, R = b * LP + r, pos = r - PADR;
                        const float q1 = bf2f(qraw[(size_t)R * 1024 + c]), q2 = bf2f(qraw[(size_t)R * 1024 + pc]);
                        const float k1 = bf2f(kraw[(size_t)R * 1024 + c]), k2 = bf2f(kraw[(size_t)R * 1024 + pc]);
                        const f32x2 cs = ROPE[pos * 64 + (d & 63)];
                        const float qr = (d < 64) ? (q1 * cs.x - q2 * cs.y) : (q2 * cs.y + q1 * cs.x);
                        const float kr = ((d < 64) ? (k1 * cs.x - k2 * cs.y) : (k2 * cs.y + k1 * cs.x)) * 0.08838834764831845f;
                        const float bj = lg * (float)(j + 1);
                        qd[(size_t)R * 1024 + c] = f2bf(qr * __expf(bj));
                        kv[jj] = kr * __expf(-bj);
                        kd[(size_t)R * 1024 + c] = f2bf(kv[jj]);
                    }
                    kp[0] = cvt_pk_bf16(kv[0], kv[1]); kp[1] = cvt_pk_bf16(kv[2], kv[3]); kp[2] = cvt_pk_bf16(kv[4], kv[5]); kp[3] = cvt_pk_bf16(kv[6], kv[7]);
                } else {
#pragma unroll
                    for (int jj = 0; jj < 8; ++jj) { const int R = b * LP + r0 + j8 * 8 + jj; qd[(size_t)R * 1024 + c] = 0; kd[(size_t)R * 1024 + c] = 0; }
                }
                *(u32x4*)(ktp + j8 * 8) = (u32x4){kp[0], kp[1], kp[2], kp[3]};
            }
        } else {
            const int h = c >> 8, d = c & 255;
            float wg[16];
#pragma unroll
            for (int r = 0; r < 16; ++r) wg[r] = C.w_gate[r * 1024 + c];
            const float bg = C.b_gate[c];
            bf16_t* ktp = kt + (size_t)((b * 4 + h) * 256 + d) * LP + r0;
            float bc = 0.f;
            for (int j8 = 0; j8 < 16; ++j8) {
                unsigned kp[4] = {0u, 0u, 0u, 0u};
                if (j8 >= npad8) {
                    float kv[8];
#pragma unroll
                    for (int jj = 0; jj < 8; ++jj) {
                        const int R = b * LP + r0 + j8 * 8 + jj;
                        const f32x4 g0 = *(const f32x4*)(GLOW + (size_t)R * 16), g1 = *(const f32x4*)(GLOW + (size_t)R * 16 + 4), g2 = *(const f32x4*)(GLOW + (size_t)R * 16 + 8), g3 = *(const f32x4*)(GLOW + (size_t)R * 16 + 12);
                        float xg = bg;
                        xg += g0[0] * wg[0] + g0[1] * wg[1] + g0[2] * wg[2] + g0[3] * wg[3]; xg += g1[0] * wg[4] + g1[1] * wg[5] + g1[2] * wg[6] + g1[3] * wg[7];
                        xg += g2[0] * wg[8] + g2[1] * wg[9] + g2[2] * wg[10] + g2[3] * wg[11]; xg += g3[0] * wg[12] + g3[1] * wg[13] + g3[2] * wg[14] + g3[3] * wg[15];
                        const float la = (fminf(xg, 0.f) - __logf(1.f + __expf(-fabsf(xg)))) * 0.0625f;
                        bc += la;
                        const float q = bf2f(qraw[(size_t)R * 1024 + c]), k = bf2f(kraw[(size_t)R * 1024 + c]);
                        qd[(size_t)R * 1024 + c] = f2bf(q * 0.0625f * __expf(bc));
                        kv[jj] = k * __expf(-bc);
                        kd[(size_t)R * 1024 + c] = f2bf(kv[jj]);
                    }
                    kp[0] = cvt_pk_bf16(kv[0], kv[1]); kp[1] = cvt_pk_bf16(kv[2], kv[3]); kp[2] = cvt_pk_bf16(kv[4], kv[5]); kp[3] = cvt_pk_bf16(kv[6], kv[7]);
                } else {
#pragma unroll
                    for (int jj = 0; jj < 8; ++jj) { const int R = b * LP + r0 + j8 * 8 + jj; qd[(size_t)R * 1024 + c] = 0; kd[(size_t)R * 1024 + c] = 0; }
                }
                *(u32x4*)(ktp + j8 * 8) = (u32x4){kp[0], kp[1], kp[2], kp[3]};
            }
            DEC1[((b * 4 + h) * NCH + n) * 256 + d] = __expf(bc);
        }
    } else {
        const int v = (part - 2) * 512 + tid;
        const bf16_t* vraw = LAYER == 0 ? V0RAW : V1RAW; bf16_t* vt = (LAYER == 0 ? VT0 : VT1) + (size_t)(b * 2048 + v) * LP + r0;
        for (int j8 = 0; j8 < 16; ++j8) {
            unsigned short e[8];
#pragma unroll
            for (int jj = 0; jj < 8; ++jj) { const int R = b * LP + r0 + j8 * 8 + jj; e[jj] = (j8 >= npad8) ? vraw[(size_t)R * 2048 + v] : (unsigned short)0; }
            u32x4 w; w.x = e[0] | ((unsigned)e[1] << 16); w.y = e[2] | ((unsigned)e[3] << 16); w.z = e[4] | ((unsigned)e[5] << 16); w.w = e[6] | ((unsigned)e[7] << 16);
            *(u32x4*)(vt + j8 * 8) = w;
        }
    }
}

template <bool FULL>
__device__ __forceinline__ void s5_task(const Ctx& C, int task, int lane, LAS bf16_t* xs) {
    const int b = task / (64 * NCH), g = (task / NCH) % 64, n = task % NCH, p = lane, gp = g * 64 + p;
    float bbr[16], bbi[16];
#pragma unroll
    for (int h = 0; h < 16; ++h) { bbr[h] = S5BB[gp * 32 + h]; bbi[h] = S5BB[gp * 32 + 16 + h]; }
    const f32x2 a = S5AB[gp];
    float xr = 0.f, xi = 0.f;
    bf16x8 cf[4];
    float dv = 0.f;
    const int fr = lane & 15, fq = lane >> 4;
    if (FULL) {
        const f32x2 a128 = S5A128[gp];
        const float* e = S5E + (size_t)((b * 64 + g) * NCH) * 128;
        for (int m = 0; m < n; ++m) { const float er = e[m * 128 + p], ei = e[m * 128 + 64 + p]; const float nr = a128.x * xr - a128.y * xi + er, ni = a128.x * xi + a128.y * xr + ei; xr = nr; xi = ni; }
#pragma unroll
        for (int kk = 0; kk < 4; ++kk) cf[kk] = *(const bf16x8*)(S5C + (g * 16 + fr) * 128 + kk * 32 + fq * 8);
        dv = C.s5d[g * 16 + fr];
    }
    const int j16s = (n == 0) ? 7 : 0;
    for (int j16 = j16s; j16 < 8; ++j16) {
        const int Rb = b * LP + n * 128 + j16 * 16;
#pragma unroll 4
        for (int jj = 0; jj < 16; ++jj) {
            const bf16_t* up = U0 + (size_t)(Rb + jj) * 1024 + g * 16;
            const u32x4 w0 = *(const u32x4*)up, w1 = *(const u32x4*)(up + 8);
            unsigned sw[8];
            sw[0] = __builtin_amdgcn_readfirstlane(w0.x); sw[1] = __builtin_amdgcn_readfirstlane(w0.y); sw[2] = __builtin_amdgcn_readfirstlane(w0.z); sw[3] = __builtin_amdgcn_readfirstlane(w0.w);
            sw[4] = __builtin_amdgcn_readfirstlane(w1.x); sw[5] = __builtin_amdgcn_readfirstlane(w1.y); sw[6] = __builtin_amdgcn_readfirstlane(w1.z); sw[7] = __builtin_amdgcn_readfirstlane(w1.w);
            float bur = 0.f, bui = 0.f;
#pragma unroll
            for (int i = 0; i < 8; ++i) { const float u0 = bflo(sw[i]), u1 = bfhi(sw[i]); bur += u0 * bbr[2 * i] + u1 * bbr[2 * i + 1]; bui += u0 * bbi[2 * i] + u1 * bbi[2 * i + 1]; }
            const float nr = a.x * xr - a.y * xi + bur, ni = a.x * xi + a.y * xr + bui; xr = nr; xi = ni;
            if (FULL) { xs[jj * 136 + p] = f2bf(xr); xs[jj * 136 + 64 + p] = f2bf(xi); }
        }
        if (FULL) {
            f32x4 acc = {0.f, 0.f, 0.f, 0.f};
            LDS_FENCE();
            bf16x8 af[4];
#pragma unroll
            for (int kk = 0; kk < 4; ++kk) af[kk] = *(const LAS bf16x8*)(xs + fr * 136 + kk * 32 + fq * 8);
            LDS_FENCE();
#pragma unroll
            for (int kk = 0; kk < 4; ++kk) acc = mfma16(af[kk], cf[kk], acc);
#pragma unroll
            for (int j = 0; j < 4; ++j) { const size_t o = (size_t)(Rb + 4 * fq + j) * 1024 + g * 16 + fr; const float y = acc[j] + dv * bf2f(U0[o]); YG[o] = f2bf(gelu_tanh(y)); }
        }
    }
    if (!FULL) { float* e = S5E + (size_t)((b * 64 + g) * NCH + n) * 128; e[p] = xr; e[64 + p] = xi; }
}

template <int LAYER>
__device__ __forceinline__ void kvscan_task(const Ctx& C, int task, int lane) {
    constexpr int H = LAYER == 0 ? 8 : 4, DK = LAYER == 0 ? 128 : 256, DV = LAYER == 0 ? 256 : 512, NDB = DK / 64, NVB = DV / 16;
    const int db = task % NDB, vb = (task / NDB) % NVB, bh = task / (NDB * NVB), h = bh % H;
    const int fr = lane & 15, fq = lane >> 4, d0 = db * 64, v0 = vb * 16;
    const bf16_t* kt = (LAYER == 0 ? KT0 : KT1) + (size_t)(bh * DK + d0 + fr) * LP + fq * 8;
    const bf16_t* vt = (LAYER == 0 ? VT0 : VT1) + (size_t)(bh * DV + v0 + fr) * LP + fq * 8;
    bf16_t* sp = (LAYER == 0 ? SP0 : SP1) + (size_t)(bh * NCH) * DV * DK + (size_t)(v0 + fr) * DK + d0 + 4 * fq;
    const float g128 = (LAYER == 0) ? (float)exp(128.0 * log1p(-exp2(-5.0 - (double)h))) : 1.f;
    f32x4 acc[4];
#pragma unroll
    for (int i = 0; i < 4; ++i) acc[i] = (f32x4){0.f, 0.f, 0.f, 0.f};
    bf16x8 fa[4][4], fb[4];
#pragma unroll
    for (int kk = 0; kk < 4; ++kk) { fb[kk] = *(const bf16x8*)(vt + kk * 32);
#pragma unroll
        for (int blk = 0; blk < 4; ++blk) fa[blk][kk] = *(const bf16x8*)(kt + (size_t)(blk * 16) * LP + kk * 32); }
    for (int n = 0; n < NCH; ++n) {
#pragma unroll
        for (int blk = 0; blk < 4; ++blk) { u32x2 w; w.x = cvt_pk_bf16(acc[blk][0], acc[blk][1]); w.y = cvt_pk_bf16(acc[blk][2], acc[blk][3]); *(u32x2*)(sp + (size_t)n * DV * DK + blk * 16) = w; }
        if (n == NCH - 1) break;
        bf16x8 na[4][4], nb[4];
        const int nn = (n + 1 < NCH - 1) ? n + 1 : n;
#pragma unroll
        for (int kk = 0; kk < 4; ++kk) { nb[kk] = *(const bf16x8*)(vt + nn * 128 + kk * 32);
#pragma unroll
            for (int blk = 0; blk < 4; ++blk) na[blk][kk] = *(const bf16x8*)(kt + (size_t)(blk * 16) * LP + nn * 128 + kk * 32); }
#pragma unroll
        for (int kk = 0; kk < 4; ++kk)
#pragma unroll
            for (int blk = 0; blk < 4; ++blk) acc[blk] = mfma16(fa[blk][kk], fb[kk], acc[blk]);
        if (LAYER == 0) {
#pragma unroll
            for (int blk = 0; blk < 4; ++blk) acc[blk] = acc[blk] * g128;
        } else {
#pragma unroll
            for (int blk = 0; blk < 4; ++blk) { const f32x4 dc = *(const f32x4*)(DEC1 + (size_t)(bh * NCH + n) * DK + d0 + blk * 16 + 4 * fq); acc[blk] = acc[blk] * dc; }
        }
#pragma unroll
        for (int kk = 0; kk < 4; ++kk) { fb[kk] = nb[kk];
#pragma unroll
            for (int blk = 0; blk < 4; ++blk) fa[blk][kk] = na[blk][kk]; }
    }
}

template <int LAYER>
__device__ __forceinline__ void mixout_task(const Ctx& C, int task, int lane, LAS bf16_t* xs) {
    constexpr int H = LAYER == 0 ? 8 : 4, DK = LAYER == 0 ? 128 : 256, DV = LAYER == 0 ? 256 : 512, NKK = DK / 32, NVB = DV / 16;
    constexpr int TPB = LAYER == 0 ? 257 : 256;
    const int bh = task / TPB, rem = task % TPB, b = bh / H, h = bh % H;
    const int n = (rem == 256) ? 0 : 1 + (rem >> 3), rb = (rem == 256) ? 7 : (rem & 7);
    const int fr = lane & 15, fq = lane >> 4;
    const bf16_t* qd = LAYER == 0 ? QD0 : QD1; const bf16_t* kd = LAYER == 0 ? KD0 : KD1;
    const int Rc = b * LP + n * 128, R0 = Rc + rb * 16;
    bf16x8 qf[NKK];
#pragma unroll
    for (int kk = 0; kk < NKK; ++kk) qf[kk] = *(const bf16x8*)(qd + (size_t)(R0 + fr) * 1024 + h * DK + kk * 32 + fq * 8);
    for (int jb = 0; jb <= rb; ++jb) {
        f32x4 s = {0.f, 0.f, 0.f, 0.f};
        const bf16_t* kp = kd + (size_t)(Rc + jb * 16 + fr) * 1024 + h * DK + fq * 8;
#pragma unroll
        for (int kk = 0; kk < NKK; ++kk) s = mfma16(qf[kk], *(const bf16x8*)(kp + kk * 32), s);
#pragma unroll
        for (int j = 0; j < 4; ++j) { float v = s[j]; if (jb == rb && fr > 4 * fq + j) v = 0.f; xs[(4 * fq + j) * 136 + jb * 16 + fr] = f2bf(v); }
    }
    if ((rb & 1) == 0) {
#pragma unroll
        for (int j = 0; j < 4; ++j) xs[(4 * fq + j) * 136 + (rb + 1) * 16 + fr] = 0;
    }
    const int nks = (rb >> 1) + 1;
    bf16x8 sf[4];
    LDS_FENCE();
#pragma unroll
    for (int kk = 0; kk < 4; ++kk) sf[kk] = *(const LAS bf16x8*)(xs + fr * 136 + (kk < nks ? kk : 0) * 32 + fq * 8);
    LDS_FENCE();
    const bf16_t* vt = (LAYER == 0 ? VT0 : VT1) + (size_t)(bh * DV + fr) * LP + n * 128 + fq * 8;
    const bf16_t* sp = (LAYER == 0 ? SP0 : SP1) + (size_t)(bh * NCH + n) * DV * DK + (size_t)fr * DK + fq * 8;
    f32x4 acc[NVB];
    float ssq[4] = {0.f, 0.f, 0.f, 0.f};
#pragma unroll
    for (int vb = 0; vb < NVB; ++vb) {
        f32x4 o = {0.f, 0.f, 0.f, 0.f};
#pragma unroll
        for (int kk = 0; kk < 4; ++kk) if (kk < nks) o = mfma16(sf[kk], *(const bf16x8*)(vt + (size_t)(vb * 16) * LP + kk * 32), o);
#pragma unroll
        for (int kk = 0; kk < NKK; ++kk) if (DBG_INTER) o = mfma16(qf[kk], *(const bf16x8*)(sp + (size_t)(vb * 16) * DK + kk * 32), o);
        acc[vb] = o;
#pragma unroll
        for (int j = 0; j < 4; ++j) ssq[j] += o[j] * o[j];
    }
    float rstd[4];
#pragma unroll
    for (int j = 0; j < 4; ++j) { float s = ssq[j]; s += __shfl_xor(s, 1); s += __shfl_xor(s, 2); s += __shfl_xor(s, 4); s += __shfl_xor(s, 8); rstd[j] = rsqrtf(s * (1.f / DV) + EPS); }
    const float* nw = (LAYER == 0 ? C.ret_norm_w : C.gla_norm_w) + h * DV + fr;
    const bf16_t* zp = (LAYER == 0 ? ZA0 : Z1) + h * DV + fr;
    bf16_t* yp = (LAYER == 0 ? YCAT : Y1) + h * DV + fr;
    constexpr int YLD = LAYER == 0 ? 3072 : 2048;
#pragma unroll
    for (int vb = 0; vb < NVB; ++vb) {
        const float w = nw[vb * 16];
#pragma unroll
        for (int j = 0; j < 4; ++j) { const int R = R0 + 4 * fq + j; const float z = bf2f(zp[(size_t)R * 2048 + vb * 16]); yp[(size_t)R * YLD + vb * 16] = DBG_NORM ? f2bf(acc[vb][j] * rstd[j] * w * siluf_(z)) : f2bf(acc[vb][j]); }
    }
}

__global__ void __launch_bounds__(512, 2) fwd(Ctx C) {
    extern __shared__ __attribute__((aligned(16))) unsigned char lds_raw[];
    LAS unsigned char* lds = (LAS unsigned char*)lds_raw;
    cg::grid_group grid = cg::this_grid();
    const int tid = threadIdx.x, lane = tid & 63, wave = __builtin_amdgcn_readfirstlane(tid >> 6), bid = blockIdx.x, G = gridDim.x;
    const int gw = wave * G + bid, NGW = G * 8;
    LAS bf16_t* xs = (LAS bf16_t*)(lds + wave * 16384);
    LAS int* slot = (LAS int*)(lds + 131072);
    const int lo = C.ph_lo, hi = C.ph_hi;
#define IN(k) (lo <= (k) && (k) < hi)
#define SEAM(k) do { if (IN(k) && IN((k) + 1)) grid.sync(); } while (0)

    if (IN(0)) p0_phase(C, lds, tid, lane, wave, bid, G);
    SEAM(0);
    if (IN(1)) {
        pg8::Gemm g{A0, W1T, 2048, 2048, 2048}; pg8::StaticOrder S; S.init(8192, 8192, G, bid);
        pg8::EpiProj<0> E{C};
        pg8::gemm_phase(lds, g, S, E);
        for (int t = gw; t < 512; t += NGW) {
            const f32x4 acc = skinny16(A0 + (size_t)PADR * 2048, 2048, W1T + (size_t)t * 16 * 2048, 2048, 2048, lane);
            bf16_t* dst; int ld, cc; pg8::route(C, 0, t * 16, dst, ld, cc);
#pragma unroll
            for (int j = 0; j < 4; ++j) { const int R = PADR + 4 * (lane >> 4) + j; const bf16_t v = f2bf(acc[j]); dst[(size_t)R * ld + cc + (lane & 15)] = v; dst[(size_t)(R + LP) * ld + cc + (lane & 15)] = v; }
        }
    }
    SEAM(1);
    if (IN(2)) {
        for (;;) { __syncthreads(); if (tid == 0) *slot = (int)atomicAdd(CTR + 0, 1u); __syncthreads(); const int it = *slot; if (it >= 2 * NCH * 6) break; prep_item<0>(C, it, tid); }
        for (;;) { const int t = wave_fetch(CTR + 1, lane); if (t >= 2 * 64 * NCH) break; s5_task<false>(C, t, lane, xs); }
    }
    SEAM(2);
    if (IN(3)) {
        constexpr int NK = 512, NS = 2 * 64 * NCH, NW3 = 32 * 193;
        for (;;) { const int t = wave_fetch(CTR + 2, lane); if (t >= NK + NS + NW3) break;
            if (t < NK) kvscan_task<0>(C, t, lane); else if (t < NK + NS) s5_task<true>(C, t - NK, lane, xs);
            else transpose_item(C.w_in_c, 2048, 6160, W3T, (LAS float*)xs, t - NK - NS, lane); }
    }
    SEAM(3);
    if (IN(4)) {
        pg8::Gemm g{YG, WGLUT, 1024, 1024, 1024}; pg8::SubOrder S{4, bid, 128};
        pg8::EpiGLU E{C};
        pg8::gemm_phase(lds, g, S, E);
        for (;;) { const int t = wave_fetch(CTR + 3, lane); if (t >= 64 + 16 * 257) break;
            if (t < 64) {
                const f32x4 acc = skinny16(YG + (size_t)PADR * 1024, 1024, WGLUT + (size_t)t * 16 * 1024, 1024, 1024, lane);
#pragma unroll
                for (int j = 0; j < 4; ++j) { const int R = PADR + 4 * (lane >> 4) + j, col = t * 16 + (lane & 15);
                    const float y = bf2f(YG[(size_t)R * 1024 + col]), z = bf2f(ZB0[(size_t)R * 1024 + col]); const bf16_t o = f2bf(y * sigmoidf_(acc[j]) * siluf_(z));
                    YCAT[(size_t)R * 3072 + 2048 + col] = o; YCAT[(size_t)(R + LP) * 3072 + 2048 + col] = o; }
            } else mixout_task<0>(C, t - 64, lane, xs);
        }
    }
    SEAM(4);
    if (IN(5)) {
        pg8::Gemm g{YCAT, WO1T, 3072, 3072, 3072}; pg8::StaticOrder S; S.init(8192, 2048, G, bid);
        pg8::EpiOut<0> E{C};
        pg8::gemm_phase(lds, g, S, E);
        for (int t = gw; t < 128; t += NGW) {
            const f32x4 acc = skinny16(YCAT + (size_t)PADR * 3072, 3072, WO1T + (size_t)t * 16 * 3072, 3072, 3072, lane);
            const int col = t * 16 + (lane & 15); const float w = C.norm_c_w[col];
#pragma unroll
            for (int j = 0; j < 4; ++j) { const int mr = 4 * (lane >> 4) + j; const float hv = C.meta[(size_t)mr * DM + col] + acc[j];
                const bf16_t o = f2bf(hv * w); A1[(size_t)(PADR + mr) * DM + col] = o; A1[(size_t)(LP + PADR + mr) * DM + col] = o;
                float s = hv * hv; s += __shfl_xor(s, 1); s += __shfl_xor(s, 2); s += __shfl_xor(s, 4); s += __shfl_xor(s, 8);
                if ((lane & 15) == 0) { atomicAdd(SSQ1 + PADR + mr, s); atomicAdd(SSQ1 + LP + PADR + mr, s); } }
        }
    }
    SEAM(5);
    if (IN(6)) {
        pg8::Gemm g{A1, W3T, 2048, 2048, 2048}; pg8::StaticOrder S; S.init(8192, 6144, G, bid);
        pg8::EpiProj<1> E{C};
        pg8::gemm_phase(lds, g, S, E);
        for (int t = gw; t < 514 + 192; t += NGW) {
            if (t < 514) {
                const int b = t / 257, Rb = b * LP + PADR + (t % 257) * 16;
                const f32x4 acc = skinny16(A1 + (size_t)Rb * 2048, 2048, W3T + (size_t)6144 * 2048, 2048, 2048, lane);
#pragma unroll
                for (int j = 0; j < 4; ++j) { const int R = Rb + 4 * (lane >> 4) + j; GLOW[(size_t)R * 16 + (lane & 15)] = acc[j] * rsqrtf(SSQ1[R] * (1.f / 2048.f) + EPS); }
            } else {
                const int c3 = 1024 + (t - 514) * 16;
                const f32x4 acc = skinny16(A1 + (size_t)PADR * 2048, 2048, W3T + (size_t)c3 * 2048, 2048, 2048, lane);
                bf16_t* dst; int ld, cc; pg8::route(C, 1, c3, dst, ld, cc);
#pragma unroll
                for (int j = 0; j < 4; ++j) { const int R = PADR + 4 * (lane >> 4) + j; const bf16_t v = f2bf(acc[j] * rsqrtf(SSQ1[R] * (1.f / 2048.f) + EPS));
                    dst[(size_t)R * ld + cc + (lane & 15)] = v; dst[(size_t)(R + LP) * ld + cc + (lane & 15)] = v; }
            }
        }
    }
    SEAM(6);
    if (IN(7)) {
        for (;;) { __syncthreads(); if (tid == 0) *slot = (int)atomicAdd(CTR + 4, 1u); __syncthreads(); const int it = *slot; if (it >= 2 * NCH * 6) break; prep_item<1>(C, it, tid); }
    }
    SEAM(7);
    if (IN(8)) { for (;;) { const int t = wave_fetch(CTR + 5, lane); if (t >= 1024) break; kvscan_task<1>(C, t, lane); } }
    SEAM(8);
    if (IN(9)) { for (;;) { const int t = wave_fetch(CTR + 6, lane); if (t >= 8 * 256) break; mixout_task<1>(C, t, lane, xs); } }
    SEAM(9);
    if (IN(10)) {
        pg8::Gemm g{Y1, WO2T, 2048, 2048, 2048}; pg8::StaticOrder S; S.init(8192, 2048, G, bid);
        pg8::EpiOut<1> E{C};
        pg8::gemm_phase(lds, g, S, E);
    }
    SEAM(10);
    if (IN(11)) {
        for (int r = gw; r < 8192; r += NGW) {
            const float rstd = rsqrtf(SSQ2[r] * (1.f / 2048.f) + EPS);
            float* row = C.out + (size_t)r * DM;
#pragma unroll
            for (int j = 0; j < 8; ++j) { const int c = (lane + 64 * j) * 4; const f32x4 v = *(const f32x4*)(row + c), w = *(const f32x4*)(C.final_w + c); *(f32x4*)(row + c) = v * rstd * w; }
        }
    }
#undef IN
#undef SEAM
}

__global__ void dump_k(const bf16_t* src, float* out, int n) { for (int i = blockIdx.x * blockDim.x + threadIdx.x; i < n; i += gridDim.x * blockDim.x) { if (i < 8650752) { const int row = i / 2048; out[i] = (row >= 128 && row < 4096) ? bf2f(src[(size_t)row * 3072 + (i % 2048)]) : 0.f; } } }
extern "C" void kernel_launch(void* const* d_in, const int* in_sizes, int n_in, void* d_out, int out_size, void* d_ws, size_t ws_size, hipStream_t stream) {
    static int ready = 0;
    if (!ready) {
        if (hipFuncSetAttribute((const void*)fwd, hipFuncAttributeMaxDynamicSharedMemorySize, LDS_BYTES) != hipSuccess) fprintf(stderr, "kernel_launch: hipFuncSetAttribute failed\n");
        ready = 1;
    }
    Ctx c{};
    const float** p = (const float**)&c;
    for (int i = 0; i < 22; ++i) p[i] = (const float*)d_in[i];
    c.out = (float*)d_out; c.ws = (unsigned char*)d_ws;
#ifdef MK_MULTI
    hipMemsetAsync(d_ws, 0, 268435456, stream); hipMemsetAsync(d_out, 0, (size_t)out_size * 4, stream);
    for (int ph = 0; ph < RUN_PH; ++ph) { c.ph_lo = ph; c.ph_hi = ph + 1; hipLaunchKernelGGL(fwd, dim3(256), dim3(512), LDS_BYTES, stream, c); }
#ifdef DUMP_SLOT
    hipLaunchKernelGGL(dump_k, dim3(2048), dim3(256), 0, stream, (const bf16_t*)((unsigned char*)d_ws + (size_t)DUMP_SLOT * SLOT), (float*)d_out, out_size);
#endif
#else
    c.ph_lo = 0; c.ph_hi = NPHASE;
    void* args[] = {&c};
    hipError_t e = hipLaunchCooperativeKernel((const void*)fwd, dim3(256), dim3(512), args, LDS_BYTES, stream);
    if (e != hipSuccess) fprintf(stderr, "cooperative launch failed: %s\n", hipGetErrorString(e));
#endif
}
```

```cpp
#define RUN_PH NPHASE
#define REP_MASK 0
#define DBG_INTER 1
#define DBG_NORM 1
#include <hip/hip_runtime.h>
#include <hip/hip_cooperative_groups.h>
#include <cstdio>
#include <cstdint>
namespace cg = cooperative_groups;

#define LAS __attribute__((address_space(3)))
typedef unsigned short bf16_t;
typedef short bf16x8 __attribute__((ext_vector_type(8)));
typedef float f32x4 __attribute__((ext_vector_type(4)));
typedef float f32x2 __attribute__((ext_vector_type(2)));
typedef unsigned u32x4 __attribute__((ext_vector_type(4)));
typedef unsigned u32x2 __attribute__((ext_vector_type(2)));

constexpr int DM = 2048, SEQ = 4096, LP = 4224, NR = 2 * LP, NCH = 33, PADR = 112;
constexpr float EPS = 1e-6f;
constexpr size_t SLOT = (size_t)NR * 1024 * 2;
constexpr size_t MISC = 15 * SLOT;
constexpr size_t M_CTR = 0, M_SSQ1 = 1024, M_SSQ2 = 34816, M_ROPE = 131072, M_S5AB = 2359296, M_S5A128 = M_S5AB + 32768,
                 M_S5BB = 2424832, M_S5C = 2949120, M_S5E = 3211264, M_DEC1 = 5373952, M_GLOW = 5644288, M_S5BBT = 6184960;
constexpr int LDS_BYTES = 163840;
constexpr int NPHASE = 12;

struct Ctx {
    const float *x, *meta, *norm_ab_w, *w_in_ab, *ret_norm_w, *lam_re, *lam_im, *log_dt, *b_re, *b_im, *c_re, *c_im, *s5d, *w_glu, *w_out_ab,
        *norm_c_w, *w_in_c, *w_gate, *b_gate, *gla_norm_w, *w_out_c, *final_w;
    float* out; unsigned char* ws; int ph_lo, ph_hi;
};

#define WSB(off) (C.ws + (off))
#define SL(i) ((bf16_t*)(C.ws + (size_t)(i) * SLOT))
#define W1T SL(0)
#define WO1T SL(2)
#define U0 SL(3)
#define Q0RAW SL(4)
#define K0RAW SL(5)
#define V0RAW SL(6)
#define ZA0 SL(8)
#define ZB0 SL(10)
#define WGLUT SL(11)
#define WO2T ((bf16_t*)(C.ws + 11 * SLOT + 2097152))
#define KD0 SL(12)
#define KT0 SL(13)
#define YG SL(14)
#define A0 ((bf16_t*)C.out)
#define VT0 ((bf16_t*)C.out)
#define QD0 ((bf16_t*)((unsigned char*)C.out + 2 * SLOT))
#define SP0 SL(0)
#define YCAT SL(3)
#define W3T SL(6)
#define A1 SL(0)
#define Q1RAW SL(3)
#define K1RAW SL(4)
#define V1RAW SL(8)
#define Z1 SL(12)
#define QD1 SL(5)
#define KD1 SL(10)
#define KT1 SL(14)
#define VT1 SL(0)
#define SP1 SL(6)
#define Y1 SL(3)
#define CTR ((unsigned*)WSB(MISC + M_CTR))
#define SSQ1 ((float*)WSB(MISC + M_SSQ1))
#define SSQ2 ((float*)WSB(MISC + M_SSQ2))
#define ROPE ((f32x2*)WSB(MISC + M_ROPE))
#define S5AB ((f32x2*)WSB(MISC + M_S5AB))
#define S5A128 ((f32x2*)WSB(MISC + M_S5A128))
#define S5BB ((float*)WSB(MISC + M_S5BB))
#define S5C ((bf16_t*)WSB(MISC + M_S5C))
#define S5E ((float*)WSB(MISC + M_S5E))
#define DEC1 ((float*)WSB(MISC + M_DEC1))
#define GLOW ((float*)WSB(MISC + M_GLOW))
#define S5BBT ((bf16_t*)WSB(MISC + M_S5BBT))

#define LDS_FENCE() asm volatile("s_waitcnt lgkmcnt(0)" ::: "memory")
#define LBAR() do { asm volatile("s_waitcnt lgkmcnt(0)" ::: "memory"); __builtin_amdgcn_s_barrier(); asm volatile("" ::: "memory"); } while (0)
typedef __bf16 bf16v2_t __attribute__((ext_vector_type(2)));
__device__ __forceinline__ unsigned cvt_pk_bf16(float lo, float hi) { bf16v2_t v; v.x = (__bf16)lo; v.y = (__bf16)hi; return __builtin_bit_cast(unsigned, v); }
__device__ __forceinline__ bf16_t f2bf(float f) { return (bf16_t)(cvt_pk_bf16(f, 0.f) & 0xffffu); }
__device__ __forceinline__ float bf2f(bf16_t h) { return __uint_as_float(((unsigned)h) << 16); }
__device__ __forceinline__ float bflo(unsigned w) { return __uint_as_float(w << 16); }
__device__ __forceinline__ float bfhi(unsigned w) { return __uint_as_float(w & 0xffff0000u); }
__device__ __forceinline__ float wave_sum(float v) {
#pragma unroll
    for (int o = 1; o < 64; o <<= 1) v += __shfl_xor(v, o);
    return v;
}
__device__ __forceinline__ float sigmoidf_(float x) { return 1.f / (1.f + __expf(-x)); }
__device__ __forceinline__ float siluf_(float x) { return x / (1.f + __expf(-x)); }
__device__ __forceinline__ float gelu_tanh(float x) { const float t = 0.7978845608028654f * (x + 0.044715f * x * x * x); const float th = 1.f - 2.f / (__expf(2.f * t) + 1.f); return 0.5f * x * (1.f + th); }
__device__ __forceinline__ f32x4 mfma16(bf16x8 a, bf16x8 b, f32x4 c) { return __builtin_amdgcn_mfma_f32_16x16x32_bf16(a, b, c, 0, 0, 0); }
__device__ __forceinline__ void gstore16_hidden(void* p, u32x4 v) { asm volatile("global_store_dwordx4 %0, %1, off" :: "v"(p), "v"(v) : "memory"); }
__device__ __forceinline__ void gstore8_hidden(void* p, u32x2 v) { asm volatile("global_store_dwordx2 %0, %1, off" :: "v"(p), "v"(v) : "memory"); }
__device__ __forceinline__ int wave_fetch_n(unsigned* ctr, unsigned nb, int lane) { unsigned v = 0; if (lane == 0) v = atomicAdd(ctr, nb); return (int)__builtin_amdgcn_readfirstlane(v); }
__device__ __forceinline__ int wave_fetch(unsigned* ctr, int lane) { unsigned v = 0; if (lane == 0) v = atomicAdd(ctr, 1u); return (int)__builtin_amdgcn_readfirstlane(v); }
__device__ __forceinline__ void dsincos(double x, double& s, double& c) {
    const double q = rint(x * 0.6366197723675814);
    double r = fma(-q, 1.5707963267948966, x); r = fma(-q, 6.123233995736766e-17, r);
    const int iq = ((int)q) & 3; const double r2 = r * r;
    const double sp = r * (1.0 + r2 * (-1.0 / 6 + r2 * (1.0 / 120 + r2 * (-1.0 / 5040 + r2 * (1.0 / 362880 + r2 * (-1.0 / 39916800 + r2 * (1.0 / 6227020800.0)))))));
    const double cp = 1.0 + r2 * (-0.5 + r2 * (1.0 / 24 + r2 * (-1.0 / 720 + r2 * (1.0 / 40320 + r2 * (-1.0 / 3628800 + r2 * (1.0 / 479001600.0 + r2 * (-1.0 / 87178291200.0)))))));
    s = (iq == 0) ? sp : (iq == 1) ? cp : (iq == 2) ? -sp : -cp;
    c = (iq == 0) ? cp : (iq == 1) ? -sp : (iq == 2) ? -cp : sp;
}

namespace pg8 {
constexpr int BM = 256, BK = 64, HALF = 128, HTB = HALF * BK * 2, STAGE_BYTES = 8 * HTB, NXCD = 8, WGM = 8;
__host__ __device__ __forceinline__ int lds_byte(int r, int c) { const int st = (r >> 4) * 2 + (c >> 5), rr = r & 15, cc = c & 31, ob = rr * 64 + cc * 2; return st * 1024 + (ob ^ (((ob >> 9) & 1) << 5)); }
__host__ __device__ __forceinline__ void stage_rc(int b, int& R, int& Cc) { const int st = b / 1024, sb = b % 1024, swz = sb ^ (((sb >> 9) & 1) << 5); R = (st >> 1) * 16 + swz / 64; Cc = (st & 1) * 32 + (swz % 64) / 2; }
__host__ __device__ __forceinline__ int perm32(int rho) { const int n = rho >> 4, i = rho & 15; return 8 * (i >> 2) + 4 * n + (i & 3); }
struct Unit { int pm, pn; };
struct Gemm { const bf16_t* A; const bf16_t* Bt; int lda, ldb, K; };
__device__ __forceinline__ int arow(int pm) { return (pm >> 4) * LP + 128 + (pm & 15) * 256; }
struct StaticOrder {
    int nM, nN, nwg, G, c;
    __device__ void init(int M, int N, int G_, int c_) { nM = M / BM; nN = N / BM; nwg = nM * nN; G = G_; c = c_; }
    __device__ bool next(int i, Unit& u) const {
        const long L = (long)i * G + c; if (L >= nwg) return false;
        int wgid = (int)L; { const int q = nwg / NXCD, r = nwg % NXCD, xcd = wgid % NXCD, off = wgid / NXCD; wgid = (xcd < r ? xcd * (q + 1) : r * (q + 1) + (xcd - r) * q) + off; }
        const int nig = WGM * nN, gid = wgid / nig, fm = gid * WGM, gsz = (nM - fm) < WGM ? (nM - fm) : WGM;
        u.pm = fm + ((wgid % nig) % gsz); u.pn = (wgid % nig) / gsz; return true;
    }
};
struct SubOrder {
    int nN, c, nunits;
    __device__ bool next(int i, Unit& u) const { if (i > 0 || c >= nunits) return false; u.pm = c / nN; u.pn = c % nN; return true; }
};

template <class Epi, class Sched>
__device__ __forceinline__ void gemm_phase(LAS unsigned char* lds, const Gemm g, const Sched& S, const Epi& E) {
    const int tid = threadIdx.x, wid = __builtin_amdgcn_readfirstlane(tid >> 6), lane = tid & 63, wr = wid >> 2, wc = wid & 3, fr = lane & 15, fq = lane >> 4;
    const int K = g.K, nt = K / BK;
    unsigned voffA[2], voffB[2];
#pragma unroll
    for (int i = 0; i < 2; ++i) { int R, Cc; stage_rc(tid * 16 + i * 8192, R, Cc); const int Rb = (R & ~31) + perm32(R & 31);
        voffA[i] = (unsigned)(R * g.lda + Cc) * 2u; voffB[i] = (unsigned)(Rb * g.ldb + Cc) * 2u; }
    const size_t kstep = (size_t)(BK * 2);
    const size_t hA = (size_t)HALF * g.lda * 2, hB = (size_t)HALF * g.ldb * 2;
    const unsigned ldsw = (unsigned)wid * 1024u;
    const int aoff = lds_byte(wr * 64 + fr, fq * 8), boff = lds_byte(wc * 32 + fr, fq * 8);
#define PG8_SA(b, h) (((b) * 2 + (h)) * HTB)
#define PG8_SB(b, h) ((4 + (b) * 2 + (h)) * HTB)
#define PG8_STAGE(bufoff, gbase, voff) do { _Pragma("unroll") for (int _i = 0; _i < 2; ++_i) \
        __builtin_amdgcn_global_load_lds((const unsigned*)((const char*)(gbase) + (voff)[_i]), (LAS unsigned*)(lds + (bufoff) + ldsw + _i * 8192), 16, 0, 0); } while (0)
#define PG8_LDA(dst, b, h) do { _Pragma("unroll") for (int m = 0; m < 4; ++m) _Pragma("unroll") for (int k = 0; k < 2; ++k) dst[m][k] = *(const LAS bf16x8*)(lds + PG8_SA(b, h) + aoff + m * 2048 + k * 1024); } while (0)
#define PG8_LDB(dst, b, h) do { _Pragma("unroll") for (int n = 0; n < 2; ++n) _Pragma("unroll") for (int k = 0; k < 2; ++k) dst[n][k] = *(const LAS bf16x8*)(lds + PG8_SB(b, h) + boff + n * 2048 + k * 1024); } while (0)
#define PG8_MMA(ai, bj, At, Bt) do { __builtin_amdgcn_s_setprio(1); _Pragma("unroll") for (int m = 0; m < 4; ++m) _Pragma("unroll") for (int n = 0; n < 2; ++n) _Pragma("unroll") for (int k = 0; k < 2; ++k) \
        acc[ai][bj][m][n] = __builtin_amdgcn_mfma_f32_16x16x32_bf16(Bt[n][k], At[m][k], acc[ai][bj][m][n], 0, 0, 0); __builtin_amdgcn_s_setprio(0); } while (0)
#define PG8_WAIT_V(n) asm volatile("s_waitcnt vmcnt(" #n ")" ::: "memory")
#define PG8_WAIT_L(n) asm volatile("s_waitcnt lgkmcnt(" #n ")" ::: "memory")
#define PG8_BAR __builtin_amdgcn_s_barrier()
#define PG8_SCHED __builtin_amdgcn_sched_barrier(0)
    Unit cur, nxt; int ui = 0;
    if (!S.next(0, cur)) return;
    f32x4 acc[2][2][4][2];
#pragma unroll
    for (int a = 0; a < 2; ++a)
#pragma unroll
        for (int b = 0; b < 2; ++b)
#pragma unroll
            for (int m = 0; m < 4; ++m)
#pragma unroll
                for (int n = 0; n < 2; ++n) acc[a][b][m][n] = (f32x4){0.f, 0.f, 0.f, 0.f};
    bf16x8 At[4][2], B0[2][2], B1[2][2];
    const char* cA = (const char*)g.A + (size_t)arow(cur.pm) * g.lda * 2; const char* cB = (const char*)g.Bt + (size_t)cur.pn * 256 * g.ldb * 2;
    PG8_STAGE(PG8_SB(0, 0), cB, voffB); PG8_STAGE(PG8_SB(0, 1), cB + hB, voffB); PG8_STAGE(PG8_SA(0, 0), cA, voffA); PG8_STAGE(PG8_SA(0, 1), cA + hA, voffA);
    if (wr == 1) PG8_BAR;
    PG8_WAIT_V(2); PG8_BAR;
    PG8_STAGE(PG8_SB(1, 0), cB + kstep, voffB); PG8_STAGE(PG8_SA(1, 0), cA + kstep, voffA); PG8_STAGE(PG8_SB(1, 1), cB + hB + kstep, voffB);
    PG8_WAIT_V(6); PG8_BAR;
    for (;;) {
        const bool has_next = S.next(ui + 1, nxt);
        const char* nA = has_next ? (const char*)g.A + (size_t)arow(nxt.pm) * g.lda * 2 : cA; const char* nB = has_next ? (const char*)g.Bt + (size_t)nxt.pn * 256 * g.ldb * 2 : cB;
        for (int t = 0; t < nt; t += 2) {
            const bool last = (t == nt - 2);
            const char* a1 = cA + (size_t)(t + 1) * kstep;
            const char* a2 = last ? nA : cA + (size_t)(t + 2) * kstep; const char* b2 = last ? nB : cB + (size_t)(t + 2) * kstep;
            const char* a3 = a2 + kstep; const char* b3 = b2 + kstep;
            PG8_LDB(B0, 0, 0); PG8_LDB(B1, 0, 1); PG8_SCHED; PG8_LDA(At, 0, 0); PG8_STAGE(PG8_SA(1, 1), a1 + hA, voffA);
            PG8_WAIT_V(8); PG8_WAIT_L(0); PG8_BAR; PG8_MMA(0, 0, At, B0); PG8_MMA(0, 1, At, B1); PG8_BAR; PG8_SCHED;
            PG8_LDA(At, 0, 1); PG8_STAGE(PG8_SB(0, 0), b2, voffB); PG8_STAGE(PG8_SB(0, 1), b2 + hB, voffB); PG8_STAGE(PG8_SA(0, 0), a2, voffA);
            PG8_WAIT_V(8); PG8_WAIT_L(0); PG8_BAR; PG8_MMA(1, 0, At, B0); PG8_MMA(1, 1, At, B1); PG8_BAR; PG8_SCHED;
            PG8_LDB(B0, 1, 0); PG8_LDB(B1, 1, 1); PG8_SCHED; PG8_LDA(At, 1, 0); PG8_STAGE(PG8_SA(0, 1), a2 + hA, voffA);
            PG8_WAIT_V(8); PG8_WAIT_L(0); PG8_BAR; PG8_MMA(0, 0, At, B0); PG8_MMA(0, 1, At, B1); PG8_BAR; PG8_SCHED;
            PG8_LDA(At, 1, 1); PG8_STAGE(PG8_SB(1, 0), b3, voffB); PG8_STAGE(PG8_SB(1, 1), b3 + hB, voffB); PG8_STAGE(PG8_SA(1, 0), a3, voffA);
            PG8_WAIT_V(8); PG8_WAIT_L(0); PG8_BAR; PG8_MMA(1, 0, At, B0); PG8_MMA(1, 1, At, B1); PG8_BAR; PG8_SCHED;
        }
        if (wr == 0) PG8_BAR;
        E(acc, cur, wr, wc, fr, fq);
        if (!has_next) break;
#pragma unroll
        for (int a = 0; a < 2; ++a)
#pragma unroll
            for (int b = 0; b < 2; ++b)
#pragma unroll
                for (int m = 0; m < 4; ++m)
#pragma unroll
                    for (int n = 0; n < 2; ++n) acc[a][b][m][n] = (f32x4){0.f, 0.f, 0.f, 0.f};
        cur = nxt; cA = nA; cB = nB; ++ui;
        if (wr == 1) PG8_BAR;
    }
    PG8_WAIT_V(0);
    PG8_BAR;
#undef PG8_SA
#undef PG8_SB
#undef PG8_STAGE
#undef PG8_LDA
#undef PG8_LDB
#undef PG8_MMA
#undef PG8_WAIT_V
#undef PG8_WAIT_L
#undef PG8_BAR
#undef PG8_SCHED
}
typedef f32x4 Acc[2][2][4][2];

__device__ __forceinline__ void route(const Ctx& C, int layer, int c0, bf16_t*& dst, int& ld, int& cc) {
    if (layer == 0) {
        if (c0 < 1024) { dst = Q0RAW; ld = 1024; cc = c0; } else if (c0 < 2048) { dst = K0RAW; ld = 1024; cc = c0 - 1024; }
        else if (c0 < 4096) { dst = V0RAW; ld = 2048; cc = c0 - 2048; } else if (c0 < 6144) { dst = ZA0; ld = 2048; cc = c0 - 4096; }
        else if (c0 < 7168) { dst = U0; ld = 1024; cc = c0 - 6144; } else { dst = ZB0; ld = 1024; cc = c0 - 7168; }
    } else {
        if (c0 < 1024) { dst = Q1RAW; ld = 1024; cc = c0; } else if (c0 < 2048) { dst = K1RAW; ld = 1024; cc = c0 - 1024; }
        else if (c0 < 4096) { dst = V1RAW; ld = 2048; cc = c0 - 2048; } else { dst = Z1; ld = 2048; cc = c0 - 4096; }
    }
}
template <int LAYER> struct EpiProj {
    Ctx C;
    __device__ __forceinline__ void operator()(const Acc& acc, const Unit& u, int wr, int wc, int fr, int fq) const {
        bf16_t* dst; int ld, c0; route(C, LAYER, u.pn * 256, dst, ld, c0);
        const int rbase = arow(u.pm);
#pragma unroll
        for (int ai = 0; ai < 2; ++ai)
#pragma unroll
            for (int m = 0; m < 4; ++m) {
                const int R = rbase + ai * 128 + wr * 64 + m * 16 + fr;
                float sc = 1.f; if (LAYER == 1) sc = rsqrtf(SSQ1[R] * (1.f / 2048.f) + EPS);
#pragma unroll
                for (int bj = 0; bj < 2; ++bj) {
                    const int cl = c0 + bj * 128 + wc * 32 + 8 * fq; const f32x4 v0 = acc[ai][bj][m][0] * sc, v1 = acc[ai][bj][m][1] * sc;
                    u32x4 w; w.x = cvt_pk_bf16(v0[0], v0[1]); w.y = cvt_pk_bf16(v0[2], v0[3]); w.z = cvt_pk_bf16(v1[0], v1[1]); w.w = cvt_pk_bf16(v1[2], v1[3]);
                    *(u32x4*)(dst + (size_t)R * ld + cl) = w;
                }
            }
    }
};
struct EpiGLU {
    Ctx C;
    __device__ __forceinline__ void operator()(const Acc& acc, const Unit& u, int wr, int wc, int fr, int fq) const {
        const int rbase = arow(u.pm), c0 = u.pn * 256;
#pragma unroll
        for (int ai = 0; ai < 2; ++ai)
#pragma unroll
            for (int m = 0; m < 4; ++m) {
                const int R = rbase + ai * 128 + wr * 64 + m * 16 + fr;
#pragma unroll
                for (int bj = 0; bj < 2; ++bj) {
                    const int cl = c0 + bj * 128 + wc * 32 + 8 * fq;
                    const u32x4 yv = *(const u32x4*)(YG + (size_t)R * 1024 + cl), zv = *(const u32x4*)(ZB0 + (size_t)R * 1024 + cl);
                    const f32x4 a0 = acc[ai][bj][m][0], a1 = acc[ai][bj][m][1];
                    float o[8];
                    o[0] = bflo(yv.x) * sigmoidf_(a0[0]) * siluf_(bflo(zv.x)); o[1] = bfhi(yv.x) * sigmoidf_(a0[1]) * siluf_(bfhi(zv.x));
                    o[2] = bflo(yv.y) * sigmoidf_(a0[2]) * siluf_(bflo(zv.y)); o[3] = bfhi(yv.y) * sigmoidf_(a0[3]) * siluf_(bfhi(zv.y));
                    o[4] = bflo(yv.z) * sigmoidf_(a1[0]) * siluf_(bflo(zv.z)); o[5] = bfhi(yv.z) * sigmoidf_(a1[1]) * siluf_(bfhi(zv.z));
                    o[6] = bflo(yv.w) * sigmoidf_(a1[2]) * siluf_(bflo(zv.w)); o[7] = bfhi(yv.w) * sigmoidf_(a1[3]) * siluf_(bfhi(zv.w));
                    u32x4 w; w.x = cvt_pk_bf16(o[0], o[1]); w.y = cvt_pk_bf16(o[2], o[3]); w.z = cvt_pk_bf16(o[4], o[5]); w.w = cvt_pk_bf16(o[6], o[7]);
                    *(u32x4*)(YCAT + (size_t)R * 3072 + 2048 + cl) = w;
                }
            }
    }
};
template <int LAYER> struct EpiOut {
    Ctx C;
    __device__ __forceinline__ void operator()(const Acc& acc, const Unit& u, int wr, int wc, int fr, int fq) const {
        const int rbase = arow(u.pm);
        const float* base = (LAYER == 0) ? C.x : C.out;
#pragma unroll
        for (int ai = 0; ai < 2; ++ai)
#pragma unroll
            for (int m = 0; m < 4; ++m) {
                const int rl = ai * 128 + wr * 64 + m * 16 + fr, R = rbase + rl, xr = u.pm * 256 + rl;
                float s = 0.f;
#pragma unroll
                for (int bj = 0; bj < 2; ++bj) {
                    const int cl = u.pn * 256 + bj * 128 + wc * 32 + 8 * fq;
                    const f32x4 h0 = *(const f32x4*)(base + (size_t)xr * DM + cl) + acc[ai][bj][m][0], h1 = *(const f32x4*)(base + (size_t)xr * DM + cl + 4) + acc[ai][bj][m][1];
                    *(f32x4*)(C.out + (size_t)xr * DM + cl) = h0; *(f32x4*)(C.out + (size_t)xr * DM + cl + 4) = h1;
                    s += (h0[0] * h0[0] + h0[1] * h0[1]) + (h0[2] * h0[2] + h0[3] * h0[3]) + (h1[0] * h1[0] + h1[1] * h1[1]) + (h1[2] * h1[2] + h1[3] * h1[3]);
                    if (LAYER == 0) {
                        const f32x4 w0 = *(const f32x4*)(C.norm_c_w + cl), w1 = *(const f32x4*)(C.norm_c_w + cl + 4);
                        u32x4 w; w.x = cvt_pk_bf16(h0[0] * w0[0], h0[1] * w0[1]); w.y = cvt_pk_bf16(h0[2] * w0[2], h0[3] * w0[3]); w.z = cvt_pk_bf16(h1[0] * w1[0], h1[1] * w1[1]); w.w = cvt_pk_bf16(h1[2] * w1[2], h1[3] * w1[3]);
                        *(u32x4*)(A1 + (size_t)R * DM + cl) = w;
                    }
                }
                s += __shfl_xor(s, 16); s += __shfl_xor(s, 32);
                if (fq == 0) unsafeAtomicAdd((LAYER == 0) ? (SSQ1 + R) : (SSQ2 + xr), s);
            }
    }
};
}

__device__ __forceinline__ f32x4 skinny16(const bf16_t* Ap, int lda, const bf16_t* Bp, int ldb, int K, int lane) {
    const bf16_t* a = Ap + (size_t)(lane & 15) * lda + (lane >> 4) * 8;
    const bf16_t* b = Bp + (size_t)(lane & 15) * ldb + (lane >> 4) * 8;
    f32x4 acc = {0.f, 0.f, 0.f, 0.f};
#pragma unroll 8
    for (int k = 0; k < K; k += 32) { const bf16x8 av = *(const bf16x8*)(a + k), bv = *(const bf16x8*)(b + k); acc = mfma16(av, bv, acc); }
    return acc;
}

__device__ __forceinline__ f32x4 skinny16_wg(const bf16_t* Ap, int lda, const bf16_t* Bp, int ldb, int K, LAS unsigned char* lds, int wave, int lane) {
    const int kw = K >> 3;
    const f32x4 part = skinny16(Ap + wave * kw, lda, Bp + wave * kw, ldb, kw, lane);
    LAS f32x4* red = (LAS f32x4*)lds;
    red[wave * 64 + lane] = part;
    __syncthreads();
    f32x4 r = red[lane];
#pragma unroll
    for (int w = 1; w < 8; ++w) r += red[w * 64 + lane];
    __syncthreads();
    return r;
}

__device__ __forceinline__ void transpose_item(const float* W, int K, int N, bf16_t* WT, LAS float* scr, int item, int lane) {
    const int nblk = (N + 31) / 32, kb = item / nblk, nb = item % nblk, k0 = 64 * kb, n0 = 32 * nb;
    const int nn = n0 + (lane & 31);
#pragma unroll 8
    for (int i = 0; i < 32; ++i) { const int kk = 2 * i + (lane >> 5); scr[kk * 33 + (lane & 31)] = (nn < N) ? W[(size_t)(k0 + kk) * N + nn] : 0.f; }
    LDS_FENCE();
    const int c = lane & 7;
#pragma unroll
    for (int j = 0; j < 4; ++j) { const int n = (lane >> 3) + 8 * j; const LAS float* s = scr + (8 * c) * 33 + n;
        u32x4 o; o.x = cvt_pk_bf16(s[0 * 33], s[1 * 33]); o.y = cvt_pk_bf16(s[2 * 33], s[3 * 33]); o.z = cvt_pk_bf16(s[4 * 33], s[5 * 33]); o.w = cvt_pk_bf16(s[6 * 33], s[7 * 33]);
        if (n0 + n < N) *(u32x4*)(WT + (size_t)(n0 + n) * K + k0 + 8 * c) = o; }
    LDS_FENCE();
}

__device__ __forceinline__ void transpose_item64(const float* W, int K, int N, bf16_t* WT, LAS float* scr, int item, int lane) {
    const int nblk = N / 64, kb = item / nblk, nb = item % nblk, k0 = 64 * kb, n0 = 64 * nb;
    const float* src = W + (size_t)(k0 + (lane >> 4)) * N + n0 + (lane & 15) * 4;
#pragma unroll
    for (int i = 0; i < 16; ++i) { const f32x4 v = *(const f32x4*)(src + (size_t)(4 * i) * N); LAS float* d = scr + (4 * i + (lane >> 4)) * 65 + (lane & 15) * 4; d[0] = v[0]; d[1] = v[1]; d[2] = v[2]; d[3] = v[3]; }
    LDS_FENCE();
    const int c = lane & 7;
#pragma unroll
    for (int j = 0; j < 8; ++j) { const int n = (lane >> 3) + 8 * j; const LAS float* t = scr + (8 * c) * 65 + n;
        u32x4 o; o.x = cvt_pk_bf16(t[0 * 65], t[1 * 65]); o.y = cvt_pk_bf16(t[2 * 65], t[3 * 65]); o.z = cvt_pk_bf16(t[4 * 65], t[5 * 65]); o.w = cvt_pk_bf16(t[6 * 65], t[7 * 65]);
        *(u32x4*)(WT + (size_t)(n0 + n) * K + k0 + 8 * c) = o; }
    LDS_FENCE();
}

__device__ __forceinline__ void p0_phase(const Ctx& C, LAS unsigned char* lds, int tid, int lane, int wave, int bid, int G) {
    LAS float* scr = (LAS float*)(lds + wave * 18432);
    const int gw = wave * G + bid, NGW = G * 8;
    constexpr int I1 = (2048 / 64) * (8192 / 64), IG = (1024 / 64) * (1024 / 64), IO1 = (3072 / 64) * (2048 / 64), IO2 = (2048 / 64) * (2048 / 64);
    for (int it = gw; it < I1 + IG + IO1 + IO2; it += NGW) {
        int r = it;
        if (r < I1) { transpose_item64(C.w_in_ab, 2048, 8192, W1T, scr, r, lane); continue; } r -= I1;
        if (r < IG) { transpose_item64(C.w_glu, 1024, 1024, WGLUT, scr, r, lane); continue; } r -= IG;
        if (r < IO1) { transpose_item64(C.w_out_ab, 3072, 2048, WO1T, scr, r, lane); continue; } r -= IO1;
        transpose_item64(C.w_out_c, 2048, 2048, WO2T, scr, r, lane);
    }
    for (int idx = gw; idx < 2 * 4112; idx += NGW) {
        const int b = idx / 4112, rr = idx % 4112;
        const float* src = (rr < 16) ? (C.meta + (size_t)rr * DM) : (C.x + ((size_t)b * SEQ + (rr - 16)) * DM);
        f32x4 v[8]; float s = 0.f;
#pragma unroll
        for (int j = 0; j < 8; ++j) { v[j] = *(const f32x4*)(src + (lane + 64 * j) * 4); s += (v[j][0] * v[j][0] + v[j][1] * v[j][1]) + (v[j][2] * v[j][2] + v[j][3] * v[j][3]); }
        const float rstd = rsqrtf(wave_sum(s) * (1.f / 2048.f) + EPS);
        bf16_t* dst = A0 + (size_t)(b * LP + PADR + rr) * DM;
#pragma unroll
        for (int j = 0; j < 8; ++j) { const f32x4 w = *(const f32x4*)(C.norm_ab_w + (lane + 64 * j) * 4);
            u32x2 o; o.x = cvt_pk_bf16(v[j][0] * rstd * w[0], v[j][1] * rstd * w[1]); o.y = cvt_pk_bf16(v[j][2] * rstd * w[2], v[j][3] * rstd * w[3]);
            *(u32x2*)(dst + (lane + 64 * j) * 4) = o; }
    }
    const int gt = bid * 512 + tid, NGT = G * 512;
    for (int idx = gt; idx < 4112 * 64; idx += NGT) {
        const int pos = idx >> 6, i = idx & 63;
        const double inv = exp(-(double)i * (9.210340371976184 / 64.0)); double s, c; dsincos((double)pos * inv, s, c);
        ROPE[idx] = (f32x2){(float)c, (float)s};
    }
    for (int idx = gt; idx < 4096; idx += NGT) {
        const int g = idx >> 6;
        const double lr = C.lam_re[idx], li = C.lam_im[idx], dt = exp((double)C.log_dt[g]);
        const double mag = exp(lr * dt); double s, c; dsincos(li * dt, s, c); const double ar = mag * c, ai = mag * s;
        S5AB[idx] = (f32x2){(float)ar, (float)ai};
        double pr = ar, pi = ai;
#pragma unroll
        for (int q = 0; q < 7; ++q) { const double nr_ = pr * pr - pi * pi, ni_ = 2.0 * pr * pi; pr = nr_; pi = ni_; }
        S5A128[idx] = (f32x2){(float)pr, (float)pi};
        const double den = lr * lr + li * li, nr = ar - 1.0, ni = ai, fre = (nr * lr + ni * li) / den, fim = (ni * lr - nr * li) / den;
        for (int h = 0; h < 16; ++h) { const double br = C.b_re[idx * 16 + h], bi = C.b_im[idx * 16 + h];
            S5BB[idx * 32 + h] = (float)(fre * br - fim * bi); S5BB[idx * 32 + 16 + h] = (float)(fre * bi + fim * br);
            const int p_ = idx & 63;
            S5BBT[(g * 128 + p_) * 32 + h] = f2bf((float)(fre * br - fim * bi)); S5BBT[(g * 128 + p_) * 32 + 16 + h] = 0;
            S5BBT[(g * 128 + 64 + p_) * 32 + h] = f2bf((float)(fre * bi + fim * br)); S5BBT[(g * 128 + 64 + p_) * 32 + 16 + h] = 0; }
    }
    for (int idx = gt; idx < 65536; idx += NGT) { const int gh = idx >> 6, p = idx & 63; S5C[gh * 128 + p] = f2bf(C.c_re[idx]); S5C[gh * 128 + 64 + p] = f2bf(-C.c_im[idx]); }
    for (int idx = gt; idx < NR; idx += NGT) SSQ1[idx] = 0.f;
    for (int idx = gt; idx < 8192; idx += NGT) SSQ2[idx] = 0.f;
    if (gt < 64) CTR[gt] = 0u;
}

template <int LAYER>
__device__ __forceinline__ void prep_item(const Ctx& C, int item, int tid, LAS unsigned char* lds) {
    LAS unsigned char* tl = lds + (unsigned)tid * 272u;
    const int b = item / (NCH * 6), n = (item / 6) % NCH, part = item % 6, r0 = n * 128;
    const int npad8 = (n == 0) ? 14 : 0;
    if (part < 2) {
        const int c = part * 512 + tid;
        const bf16_t* qraw = LAYER == 0 ? Q0RAW : Q1RAW; const bf16_t* kraw = LAYER == 0 ? K0RAW : K1RAW;
        bf16_t* qd = LAYER == 0 ? QD0 : QD1; bf16_t* kd = LAYER == 0 ? KD0 : KD1; bf16_t* kt = LAYER == 0 ? KT0 : KT1;
        if (LAYER == 0) {
            const int h = c >> 7, d = c & 127, pc = c ^ 64;
            const float lg = (float)log1p(-exp2(-5.0 - (double)h));
            bf16_t* ktp = kt + ((size_t)((b * 8 + h) * NCH + n) * 128 + d) * 128;
            for (int j8 = 0; j8 < 16; ++j8) {
                unsigned kp[4] = {0u, 0u, 0u, 0u};
                if (j8 >= npad8) {
                    float kv[8];
#pragma unroll
                    for (int jj = 0; jj < 8; ++jj) {
                        const int j = j8 * 8 + jj, r = r0 + j, R = b * LP + r, pos = r - PADR;
                        const float q1 = bf2f(qraw[(size_t)R * 1024 + c]), q2 = bf2f(qraw[(size_t)R * 1024 + pc]);
                        const float k1 = bf2f(kraw[(size_t)R * 1024 + c]), k2 = bf2f(kraw[(size_t)R * 1024 + pc]);
                        const f32x2 cs = ROPE[pos * 64 + (d & 63)];
                        const float qr = (d < 64) ? (q1 * cs.x - q2 * cs.y) : (q2 * cs.y + q1 * cs.x);
                        const float kr = ((d < 64) ? (k1 * cs.x - k2 * cs.y) : (k2 * cs.y + k1 * cs.x)) * 0.08838834764831845f;
                        const float bj = lg * (float)(j + 1);
                        qd[(size_t)R * 1024 + c] = f2bf(qr * __expf(bj));
                        kv[jj] = kr * __expf(-bj);
                        kd[(size_t)R * 1024 + c] = f2bf(kv[jj]);
                    }
                    kp[0] = cvt_pk_bf16(kv[0], kv[1]); kp[1] = cvt_pk_bf16(kv[2], kv[3]); kp[2] = cvt_pk_bf16(kv[4], kv[5]); kp[3] = cvt_pk_bf16(kv[6], kv[7]);
                } else {
#pragma unroll
                    for (int jj = 0; jj < 8; ++jj) { const int R = b * LP + r0 + j8 * 8 + jj; qd[(size_t)R * 1024 + c] = 0; kd[(size_t)R * 1024 + c] = 0; }
                }
                *(LAS u32x4*)(tl + j8 * 16) = (u32x4){kp[0], kp[1], kp[2], kp[3]};
            }
        } else {
            const int h = c >> 8, d = c & 255;
            float wg[16];
#pragma unroll
            for (int r = 0; r < 16; ++r) wg[r] = C.w_gate[r * 1024 + c];
            const float bg = C.b_gate[c];
            bf16_t* ktp = kt + ((size_t)((b * 4 + h) * NCH + n) * 256 + d) * 128;
            float bc = 0.f;
            for (int j8 = 0; j8 < 16; ++j8) {
                unsigned kp[4] = {0u, 0u, 0u, 0u};
                if (j8 >= npad8) {
                    float kv[8];
#pragma unroll
                    for (int jj = 0; jj < 8; ++jj) {
                        const int R = b * LP + r0 + j8 * 8 + jj;
                        const f32x4 g0 = *(const f32x4*)(GLOW + (size_t)R * 16), g1 = *(const f32x4*)(GLOW + (size_t)R * 16 + 4), g2 = *(const f32x4*)(GLOW + (size_t)R * 16 + 8), g3 = *(const f32x4*)(GLOW + (size_t)R * 16 + 12);
                        float xg = bg;
                        xg += g0[0] * wg[0] + g0[1] * wg[1] + g0[2] * wg[2] + g0[3] * wg[3]; xg += g1[0] * wg[4] + g1[1] * wg[5] + g1[2] * wg[6] + g1[3] * wg[7];
                        xg += g2[0] * wg[8] + g2[1] * wg[9] + g2[2] * wg[10] + g2[3] * wg[11]; xg += g3[0] * wg[12] + g3[1] * wg[13] + g3[2] * wg[14] + g3[3] * wg[15];
                        const float la = (fminf(xg, 0.f) - __logf(1.f + __expf(-fabsf(xg)))) * 0.0625f;
                        bc += la;
                        const float q = bf2f(qraw[(size_t)R * 1024 + c]), k = bf2f(kraw[(size_t)R * 1024 + c]);
                        qd[(size_t)R * 1024 + c] = f2bf(q * 0.0625f * __expf(bc));
                        kv[jj] = k * __expf(-bc);
                        kd[(size_t)R * 1024 + c] = f2bf(kv[jj]);
                    }
                    kp[0] = cvt_pk_bf16(kv[0], kv[1]); kp[1] = cvt_pk_bf16(kv[2], kv[3]); kp[2] = cvt_pk_bf16(kv[4], kv[5]); kp[3] = cvt_pk_bf16(kv[6], kv[7]);
                } else {
#pragma unroll
                    for (int jj = 0; jj < 8; ++jj) { const int R = b * LP + r0 + j8 * 8 + jj; qd[(size_t)R * 1024 + c] = 0; kd[(size_t)R * 1024 + c] = 0; }
                }
                *(LAS u32x4*)(tl + j8 * 16) = (u32x4){kp[0], kp[1], kp[2], kp[3]};
            }
            DEC1[((b * 4 + h) * NCH + n) * 256 + d] = __expf(bc);
        }
    } else {
        const int v = (part - 2) * 512 + tid;
        constexpr int DVp = LAYER == 0 ? 256 : 512;
        const bf16_t* vraw = LAYER == 0 ? V0RAW : V1RAW; bf16_t* vt = (LAYER == 0 ? VT0 : VT1) + ((size_t)(((b * 2048 + v) / DVp) * NCH + n) * DVp + (v % DVp)) * 128;
        for (int j8 = 0; j8 < 16; ++j8) {
            unsigned short e[8] = {0, 0, 0, 0, 0, 0, 0, 0};
            if (j8 >= npad8) {
                const bf16_t* vp = vraw + (size_t)(b * LP + r0 + j8 * 8) * 2048 + v;
#pragma unroll
                for (int jj = 0; jj < 8; ++jj) e[jj] = vp[jj * 2048];
            }
            u32x4 w; w.x = e[0] | ((unsigned)e[1] << 16); w.y = e[2] | ((unsigned)e[3] << 16); w.z = e[4] | ((unsigned)e[5] << 16); w.w = e[6] | ((unsigned)e[7] << 16);
            *(LAS u32x4*)(tl + j8 * 16) = w;
        }
    }
    __syncthreads();
#pragma unroll 4
    for (int i = 0; i < 16; ++i) {
        const int p_ = tid + i * 512, rr = p_ >> 4, c8 = p_ & 15;
        bf16_t* dst;
        if (part < 2) {
            const int c = part * 512 + rr;
            if (LAYER == 0) dst = KT0 + ((size_t)((b * 8 + (c >> 7)) * NCH + n) * 128 + (c & 127)) * 128;
            else dst = KT1 + ((size_t)((b * 4 + (c >> 8)) * NCH + n) * 256 + (c & 255)) * 128;
        } else {
            constexpr int DVq = LAYER == 0 ? 256 : 512;
            const int rowid = b * 2048 + (part - 2) * 512 + rr;
            dst = (LAYER == 0 ? VT0 : VT1) + ((size_t)((rowid / DVq) * NCH + n) * DVq + (rowid % DVq)) * 128;
        }
        *(u32x4*)(dst + c8 * 8) = *(const LAS u32x4*)(lds + (unsigned)rr * 272u + c8 * 16);
    }
    __syncthreads();
}

template <bool FULL>
__device__ __forceinline__ void s5_task(const Ctx& C, int task, int lane, LAS bf16_t* xs) {
    const int b = task / (64 * NCH), g = (task / NCH) % 64, n = task % NCH, p = lane, gp = g * 64 + p;
    const int fr = lane & 15, fq = lane >> 4;
    LAS float* xf = (LAS float*)(xs + 16 * 136);
    bf16x8 bbf[8];
#pragma unroll
    for (int blk = 0; blk < 8; ++blk) bbf[blk] = *(const bf16x8*)(S5BBT + (size_t)(g * 128 + blk * 16 + fr) * 32 + fq * 8);
    const f32x2 a = S5AB[gp];
    float xr = 0.f, xi = 0.f;
    bf16x8 cf[4];
    float dv = 0.f;
    if (FULL) {
        const f32x2 a128 = S5A128[gp];
        const float* e = S5E + (size_t)((b * 64 + g) * NCH) * 128;
        for (int m0 = 0; m0 < n; m0 += 8) {
            float er[8], ei[8];
#pragma unroll
            for (int k = 0; k < 8; ++k) { const int mm = (m0 + k < n) ? m0 + k : n - 1; er[k] = e[mm * 128 + p]; ei[k] = e[mm * 128 + 64 + p]; }
#pragma unroll
            for (int k = 0; k < 8; ++k) { const float nr = a128.x * xr - a128.y * xi + er[k], ni = a128.x * xi + a128.y * xr + ei[k]; const bool ok = (m0 + k < n); xr = ok ? nr : xr; xi = ok ? ni : xi; }
        }
#pragma unroll
        for (int kk = 0; kk < 4; ++kk) cf[kk] = *(const bf16x8*)(S5C + (g * 16 + fr) * 128 + kk * 32 + fq * 8);
        dv = C.s5d[g * 16 + fr];
    }
    const int j16s = (n == 0) ? 7 : 0;
    bf16x8 uf = {0, 0, 0, 0, 0, 0, 0, 0}, ufn = {0, 0, 0, 0, 0, 0, 0, 0};
    if (fq < 2) uf = *(const bf16x8*)(U0 + (size_t)(b * LP + n * 128 + j16s * 16 + fr) * 1024 + g * 16 + fq * 8);
    bf16_t ue[4] = {0, 0, 0, 0}, uen[4] = {0, 0, 0, 0};
    if (FULL) {
#pragma unroll
        for (int j = 0; j < 4; ++j) ue[j] = U0[(size_t)(b * LP + n * 128 + j16s * 16 + 4 * fq + j) * 1024 + g * 16 + fr];
    }
    for (int j16 = j16s; j16 < 8; ++j16) {
        const int Rb = b * LP + n * 128 + j16 * 16;
        if (fq < 2 && j16 < 7) ufn = *(const bf16x8*)(U0 + (size_t)(Rb + 16 + fr) * 1024 + g * 16 + fq * 8);
        if (FULL && j16 < 7) {
#pragma unroll
            for (int j = 0; j < 4; ++j) uen[j] = U0[(size_t)(Rb + 16 + 4 * fq + j) * 1024 + g * 16 + fr];
        }
#pragma unroll
        for (int blk = 0; blk < 8; ++blk) { const f32x4 d = mfma16(uf, bbf[blk], (f32x4){0.f, 0.f, 0.f, 0.f});
#pragma unroll
            for (int j = 0; j < 4; ++j) xf[(4 * fq + j) * 132 + blk * 16 + fr] = d[j]; }
        LDS_FENCE();
#pragma unroll
        for (int jj = 0; jj < 16; ++jj) {
            const float bur = xf[jj * 132 + p], bui = xf[jj * 132 + 64 + p];
            const float nr = a.x * xr - a.y * xi + bur, ni = a.x * xi + a.y * xr + bui; xr = nr; xi = ni;
            if (FULL) { xs[jj * 136 + p] = f2bf(xr); xs[jj * 136 + 64 + p] = f2bf(xi); }
        }
        LDS_FENCE();
        if (FULL) {
            f32x4 acc = {0.f, 0.f, 0.f, 0.f};
            bf16x8 af[4];
#pragma unroll
            for (int kk = 0; kk < 4; ++kk) af[kk] = *(const LAS bf16x8*)(xs + fr * 136 + kk * 32 + fq * 8);
            LDS_FENCE();
#pragma unroll
            for (int kk = 0; kk < 4; ++kk) acc = mfma16(af[kk], cf[kk], acc);
#pragma unroll
            for (int j = 0; j < 4; ++j) { const size_t o = (size_t)(Rb + 4 * fq + j) * 1024 + g * 16 + fr; const float y = acc[j] + dv * bf2f(ue[j]); YG[o] = f2bf(gelu_tanh(y)); }
        }
        uf = ufn;
#pragma unroll
        for (int j = 0; j < 4; ++j) ue[j] = uen[j];
    }
    if (!FULL) { float* e = S5E + (size_t)((b * 64 + g) * NCH + n) * 128; e[p] = xr; e[64 + p] = xi; }
}

template <int LAYER>
__device__ __forceinline__ void kvscan_task(const Ctx& C, int task, int lane) {
    constexpr int H = LAYER == 0 ? 8 : 4, DK = LAYER == 0 ? 128 : 256, DV = LAYER == 0 ? 256 : 512, NDB = DK / 64, NVB = DV / 16;
    const int db = task % NDB, vb = (task / NDB) % NVB, bh = task / (NDB * NVB), h = bh % H;
    const int fr = lane & 15, fq = lane >> 4, d0 = db * 64, v0 = vb * 16;
    const bf16_t* kt = (LAYER == 0 ? KT0 : KT1) + (size_t)(bh * DK + d0 + fr) * LP + fq * 8;
    const bf16_t* vt = (LAYER == 0 ? VT0 : VT1) + (size_t)(bh * DV + v0 + fr) * LP + fq * 8;
    bf16_t* sp = (LAYER == 0 ? SP0 : SP1) + (size_t)(bh * NCH) * DV * DK + (size_t)(v0 + fr) * DK + d0 + 4 * fq;
    const float g128 = (LAYER == 0) ? (float)exp(128.0 * log1p(-exp2(-5.0 - (double)h))) : 1.f;
    f32x4 acc[4];
#pragma unroll
    for (int i = 0; i < 4; ++i) acc[i] = (f32x4){0.f, 0.f, 0.f, 0.f};
    bf16x8 fa[4][4], fb[4];
#pragma unroll
    for (int kk = 0; kk < 4; ++kk) { fb[kk] = *(const bf16x8*)(vt + kk * 32);
#pragma unroll
        for (int blk = 0; blk < 4; ++blk) fa[blk][kk] = *(const bf16x8*)(kt + (size_t)(blk * 16) * LP + kk * 32); }
    for (int n = 0; n < NCH; ++n) {
#pragma unroll
        for (int blk = 0; blk < 4; ++blk) { u32x2 w; w.x = cvt_pk_bf16(acc[blk][0], acc[blk][1]); w.y = cvt_pk_bf16(acc[blk][2], acc[blk][3]); *(u32x2*)(sp + (size_t)n * DV * DK + blk * 16) = w; }
        if (n == NCH - 1) break;
        bf16x8 na[4][4], nb[4];
        const int nn = (n + 1 < NCH - 1) ? n + 1 : n;
#pragma unroll
        for (int kk = 0; kk < 4; ++kk) { nb[kk] = *(const bf16x8*)(vt + nn * 128 + kk * 32);
#pragma unroll
            for (int blk = 0; blk < 4; ++blk) na[blk][kk] = *(const bf16x8*)(kt + (size_t)(blk * 16) * LP + nn * 128 + kk * 32); }
#pragma unroll
        for (int kk = 0; kk < 4; ++kk)
#pragma unroll
            for (int blk = 0; blk < 4; ++blk) acc[blk] = mfma16(fa[blk][kk], fb[kk], acc[blk]);
        if (LAYER == 0) {
#pragma unroll
            for (int blk = 0; blk < 4; ++blk) acc[blk] = acc[blk] * g128;
        } else {
#pragma unroll
            for (int blk = 0; blk < 4; ++blk) { const f32x4 dc = *(const f32x4*)(DEC1 + (size_t)(bh * NCH + n) * DK + d0 + blk * 16 + 4 * fq); acc[blk] = acc[blk] * dc; }
        }
#pragma unroll
        for (int kk = 0; kk < 4; ++kk) { fb[kk] = nb[kk];
#pragma unroll
            for (int blk = 0; blk < 4; ++blk) fa[blk][kk] = na[blk][kk]; }
    }
}

template <int LAYER>
__device__ __forceinline__ void mixout_task(const Ctx& C, int task, int lane, LAS bf16_t* xs) {
    constexpr int H = LAYER == 0 ? 8 : 4, DK = LAYER == 0 ? 128 : 256, DV = LAYER == 0 ? 256 : 512, NKK = DK / 32, NVB = DV / 16;
    constexpr int TPB = LAYER == 0 ? 257 : 256;
    const int bh = task / TPB, rem = task % TPB, b = bh / H, h = bh % H;
    const int n = (rem == 256) ? 0 : 1 + (rem >> 3), rb = (rem == 256) ? 7 : (rem & 7);
    const int fr = lane & 15, fq = lane >> 4;
    const bf16_t* qd = LAYER == 0 ? QD0 : QD1; const bf16_t* kd = LAYER == 0 ? KD0 : KD1;
    const int Rc = b * LP + n * 128, R0 = Rc + rb * 16;
    bf16x8 qf[NKK];
#pragma unroll
    for (int kk = 0; kk < NKK; ++kk) qf[kk] = *(const bf16x8*)(qd + (size_t)(R0 + fr) * 1024 + h * DK + kk * 32 + fq * 8);
    for (int jb = 0; jb <= rb; ++jb) {
        f32x4 s = {0.f, 0.f, 0.f, 0.f};
        const bf16_t* kp = kd + (size_t)(Rc + jb * 16 + fr) * 1024 + h * DK + fq * 8;
#pragma unroll
        for (int kk = 0; kk < NKK; ++kk) s = mfma16(qf[kk], *(const bf16x8*)(kp + kk * 32), s);
#pragma unroll
        for (int j = 0; j < 4; ++j) { float v = s[j]; if (jb == rb && fr > 4 * fq + j) v = 0.f; xs[(4 * fq + j) * 136 + jb * 16 + fr] = f2bf(v); }
    }
    if ((rb & 1) == 0) {
#pragma unroll
        for (int j = 0; j < 4; ++j) xs[(4 * fq + j) * 136 + (rb + 1) * 16 + fr] = 0;
    }
    const int nks = (rb >> 1) + 1;
    bf16x8 sf[4];
    LDS_FENCE();
#pragma unroll
    for (int kk = 0; kk < 4; ++kk) sf[kk] = *(const LAS bf16x8*)(xs + fr * 136 + (kk < nks ? kk : 0) * 32 + fq * 8);
    LDS_FENCE();
    const bf16_t* vt = (LAYER == 0 ? VT0 : VT1) + (size_t)(bh * DV + fr) * LP + n * 128 + fq * 8;
    const bf16_t* sp = (LAYER == 0 ? SP0 : SP1) + (size_t)(bh * NCH + n) * DV * DK + (size_t)fr * DK + fq * 8;
    f32x4 acc[NVB];
    float ssq[4] = {0.f, 0.f, 0.f, 0.f};
#pragma unroll
    for (int vb = 0; vb < NVB; ++vb) {
        f32x4 o = {0.f, 0.f, 0.f, 0.f};
#pragma unroll
        for (int kk = 0; kk < 4; ++kk) if (kk < nks) o = mfma16(sf[kk], *(const bf16x8*)(vt + (size_t)(vb * 16) * LP + kk * 32), o);
#pragma unroll
        for (int kk = 0; kk < NKK; ++kk) if (DBG_INTER) o = mfma16(qf[kk], *(const bf16x8*)(sp + (size_t)(vb * 16) * DK + kk * 32), o);
        acc[vb] = o;
#pragma unroll
        for (int j = 0; j < 4; ++j) ssq[j] += o[j] * o[j];
    }
    float rstd[4];
#pragma unroll
    for (int j = 0; j < 4; ++j) { float s = ssq[j]; s += __shfl_xor(s, 1); s += __shfl_xor(s, 2); s += __shfl_xor(s, 4); s += __shfl_xor(s, 8); rstd[j] = rsqrtf(s * (1.f / DV) + EPS); }
    const float* nw = (LAYER == 0 ? C.ret_norm_w : C.gla_norm_w) + h * DV + fr;
    const bf16_t* zp = (LAYER == 0 ? ZA0 : Z1) + h * DV + fr;
    bf16_t* yp = (LAYER == 0 ? YCAT : Y1) + h * DV + fr;
    constexpr int YLD = LAYER == 0 ? 3072 : 2048;
#pragma unroll
    for (int vb = 0; vb < NVB; ++vb) {
        const float w = nw[vb * 16];
#pragma unroll
        for (int j = 0; j < 4; ++j) { const int R = R0 + 4 * fq + j; const float z = bf2f(zp[(size_t)R * 2048 + vb * 16]); yp[(size_t)R * YLD + vb * 16] = DBG_NORM ? f2bf(acc[vb][j] * rstd[j] * w * siluf_(z)) : f2bf(acc[vb][j]); }
    }
}


__device__ __forceinline__ int block_fetch(unsigned* ctr, LAS int* slot, int tid) { __syncthreads(); if (tid == 0) *slot = (int)atomicAdd(ctr, 1u); __syncthreads(); return (int)__builtin_amdgcn_readfirstlane((unsigned)*slot); }
template <int LAYER>
__device__ __forceinline__ void kvscan_wg(const Ctx& C, int task, LAS unsigned char* lds, int tid, int lane, int wave) {
    constexpr int H = LAYER == 0 ? 8 : 4, DK = LAYER == 0 ? 128 : 256, DV = LAYER == 0 ? 256 : 512, NVG = DV / 32, NB = DK / 64, TP = 136, TILEB = DK * TP * 2, NPC = DK / 32;
    constexpr int VTO = 2 * TILEB + 2048, VTB = 32 * TP * 2;
    const int bh = task / NVG, vg = task % NVG, h = bh % H, vb = wave & 1, dh = wave >> 1, fr = lane & 15, fq = lane >> 4;
    const bf16_t* ktg = (LAYER == 0 ? KT0 : KT1) + (size_t)(bh * NCH) * DK * 128;
    const bf16_t* vtg = (LAYER == 0 ? VT0 : VT1) + (size_t)(bh * NCH) * DV * 128 + (size_t)(vg * 32) * 128;
    bf16_t* sp = (LAYER == 0 ? SP0 : SP1) + (size_t)(bh * NCH) * DV * DK + (size_t)(vg * 32 + vb * 16 + fr) * DK + dh * (DK / 4) + 4 * fq;
    const float g128 = (LAYER == 0) ? (float)exp(128.0 * log1p(-exp2(-5.0 - (double)h))) : 1.f;
    LAS float* decl = (LAS float*)(lds + 2 * TILEB);
    f32x4 acc[NB];
#pragma unroll
    for (int i = 0; i < NB; ++i) acc[i] = (f32x4){0.f, 0.f, 0.f, 0.f};
    u32x4 r0[NPC], r1[NPC], v0, v1; f32x4 d0 = {1.f, 1.f, 1.f, 1.f}, d1 = {1.f, 1.f, 1.f, 1.f};
    const unsigned kvo = (unsigned)((tid >> 4) * 128 + (tid & 15) * 8) * 2u;
    const unsigned lwo = (unsigned)((tid >> 4) * TP + (tid & 15) * 8) * 2u;
    constexpr int RB = DK / 2, VPT = 256 / RB, PPR = RB / 16, NST = 16 * PPR / 64;
    const unsigned spw = (unsigned)(((4 * wave + ((fr / VPT) & 3) + 32 * ((fr / VPT) >> 2)) * TP) * 2 + (fr % VPT) * RB + fq * 8);
    unsigned spr[NST]; bf16_t* spg[NST];
#pragma unroll
    for (int s_ = 0; s_ < NST; ++s_) { const int P_ = lane + 64 * s_, v_ = P_ / PPR, c_ = P_ % PPR, k_ = v_ / VPT;
        spr[s_] = (unsigned)(((4 * wave + (k_ & 3) + 32 * (k_ >> 2)) * TP) * 2 + (v_ % VPT) * RB + c_ * 16);
        spg[s_] = (LAYER == 0 ? SP0 : SP1) + (size_t)(bh * NCH) * DV * DK + (size_t)(vg * 32 + vb * 16 + v_) * DK + dh * (DK / 4) + c_ * 8; }
    u32x4 t_[NST];
#define KV_SPSTORE(n_, fb_) do { \
        _Pragma("unroll") for (int blk = 0; blk < NB; ++blk) { u32x2 w; w.x = cvt_pk_bf16(acc[blk][0], acc[blk][1]); w.y = cvt_pk_bf16(acc[blk][2], acc[blk][3]); *(LAS u32x2*)(lds + (fb_) * TILEB + spw + blk * 32) = w; } \
        LDS_FENCE(); \
        _Pragma("unroll") for (int s_ = 0; s_ < NST; ++s_) t_[s_] = *(const LAS u32x4*)(lds + (fb_) * TILEB + spr[s_]); \
        LDS_FENCE(); } while (0)
#define KV_SPFLUSH(n_) do { _Pragma("unroll") for (int s_ = 0; s_ < NST; ++s_) *(u32x4*)(spg[s_] + (size_t)(n_) * DV * DK) = t_[s_]; } while (0)
#define KV_LOAD(R, D, V, nn) do { _Pragma("unroll") for (int i = 0; i < NPC; ++i) { R[i] = *(const u32x4*)((const char*)(ktg + (size_t)(nn) * DK * 128 + (i * 32) * 128) + kvo); } \
        V = *(const u32x4*)((const char*)(vtg + (size_t)(nn) * DV * 128) + kvo); \
        if (LAYER == 1 && tid < DK / 4) D = *(const f32x4*)(DEC1 + (size_t)(bh * NCH + (nn)) * DK + tid * 4); } while (0)
#define KV_WRITE(R, D, V, bb) do { _Pragma("unroll") for (int i = 0; i < NPC; ++i) { *(LAS u32x4*)(lds + (bb) * TILEB + i * 32 * TP * 2 + lwo) = R[i]; } \
        *(LAS u32x4*)(lds + VTO + (bb) * VTB + lwo) = V; \
        if (LAYER == 1 && tid < DK / 4) *(LAS f32x4*)(decl + (bb) * DK + tid * 4) = D; } while (0)
#define KV_STEP(n_, RW, DW, VW) do { \
        KV_SPSTORE(n_, ((n_) + 1) & 1); \
        KV_WRITE(RW, DW, VW, ((n_) + 1) & 1); \
        KV_LOAD(RW, DW, VW, ((n_) + 3 < 32 ? (n_) + 3 : 31)); \
        KV_SPFLUSH(n_); \
        { const LAS unsigned char* tb = lds + ((n_) & 1) * TILEB + ((dh * (DK / 4) + fr) * TP + fq * 8) * 2; \
          const LAS unsigned char* vbp = lds + VTO + ((n_) & 1) * VTB + ((vb * 16 + fr) * TP + fq * 8) * 2; \
          _Pragma("unroll") for (int kk = 0; kk < 4; ++kk) { bf16x8 af[NB]; const bf16x8 bfv = *(const LAS bf16x8*)(vbp + kk * 64); \
            _Pragma("unroll") for (int blk = 0; blk < NB; ++blk) af[blk] = *(const LAS bf16x8*)(tb + (blk * 16 * TP + kk * 32) * 2); \
            _Pragma("unroll") for (int blk = 0; blk < NB; ++blk) acc[blk] = mfma16(af[blk], bfv, acc[blk]); } } \
        if (LAYER == 0) { _Pragma("unroll") for (int blk = 0; blk < NB; ++blk) acc[blk] = acc[blk] * g128; } \
        else { _Pragma("unroll") for (int blk = 0; blk < NB; ++blk) { const f32x4 dc = *(const LAS f32x4*)(decl + ((n_) & 1) * DK + dh * (DK / 4) + blk * 16 + 4 * fq); acc[blk] = acc[blk] * dc; } } \
        LBAR(); } while (0)
    KV_LOAD(r0, d0, v0, 0); KV_WRITE(r0, d0, v0, 0); KV_LOAD(r1, d1, v1, 1); KV_LOAD(r0, d0, v0, 2);
    LBAR();
    for (int nb = 0; nb < 32; nb += 2) {
        KV_STEP(nb + 0, r1, d1, v1);
        KV_STEP(nb + 1, r0, d0, v0);
    }
    KV_SPSTORE(32, 1); KV_SPFLUSH(32);
#undef KV_LOAD
#undef KV_WRITE
#undef KV_STEP
#undef KV_SPSTORE
#undef KV_SPFLUSH
    LBAR();
}

template <int LAYER>
__device__ __forceinline__ void mixout_wg(const Ctx& C, int task, LAS unsigned char* lds, int tid, int lane, int wave) {
    constexpr int H = LAYER == 0 ? 8 : 4, DK = LAYER == 0 ? 128 : 256, DV = LAYER == 0 ? 256 : 512, NKK = DK / 32, NSLAB = DV / 64, KP = DK + 8;
    constexpr int NSP = DK / 64, XSB = 8 * 4352, SPB = 64 * KP * 2, SLABB = SPB + 64 * 136 * 2, YLD = LAYER == 0 ? 3072 : 2048;
    const int bh = (LAYER == 0) ? task / NCH : task / 32, n = (LAYER == 0) ? task % NCH : 1 + task % 32, b = bh / H, h = bh % H, rb = wave;
    const int fr = lane & 15, fq = lane >> 4;
    const bf16_t* qd = LAYER == 0 ? QD0 : QD1; const bf16_t* kd = LAYER == 0 ? KD0 : KD1;
    const int Rc = b * LP + n * 128, R0 = Rc + rb * 16;
    LAS bf16_t* xs = (LAS bf16_t*)(lds + wave * 4352);
    const bf16_t* spg = (LAYER == 0 ? SP0 : SP1) + (size_t)(bh * NCH + n) * DV * DK;
    const bf16_t* vtg = (LAYER == 0 ? VT0 : VT1) + (size_t)(bh * NCH + n) * DV * 128;
    u32x4 rs[NSP], rv[2];
    const unsigned spo = (unsigned)((tid / (DK / 8)) * DK + (tid % (DK / 8)) * 8) * 2u, vto = (unsigned)((tid >> 4) * 128 + (tid & 15) * 8) * 2u;
#define MX_LOAD(s_) do { _Pragma("unroll") for (int i = 0; i < NSP; ++i) { rs[i] = *(const u32x4*)((const char*)(spg + (size_t)((s_) * 64 + i * (4096 / DK)) * DK) + spo); } \
        _Pragma("unroll") for (int i = 0; i < 2; ++i) { rv[i] = *(const u32x4*)((const char*)(vtg + (size_t)((s_) * 64 + i * 32) * 128) + vto); } } while (0)
#define MX_WRITE(bb) do { _Pragma("unroll") for (int i = 0; i < NSP; ++i) { const int p_ = tid + i * 512, row_ = p_ / (DK / 8), c8_ = p_ % (DK / 8); *(LAS u32x4*)(lds + XSB + (bb) * SLABB + (row_ * KP + c8_ * 8) * 2) = rs[i]; } \
        _Pragma("unroll") for (int i = 0; i < 2; ++i) { const int p_ = tid + i * 512, row_ = p_ >> 4, c8_ = p_ & 15; *(LAS u32x4*)(lds + XSB + (bb) * SLABB + SPB + (row_ * 136 + c8_ * 8) * 2) = rv[i]; } } while (0)
    bf16x8 qf[NKK];
#pragma unroll
    for (int kk = 0; kk < NKK; ++kk) qf[kk] = *(const bf16x8*)(qd + (size_t)(R0 + fr) * 1024 + h * DK + kk * 32 + fq * 8);
    {
        constexpr int NKP = DK / 32;
        u32x4 rk[NKP];
        const unsigned ko = (unsigned)((tid / (DK / 8)) * 1024 + (tid % (DK / 8)) * 8) * 2u;
#pragma unroll
        for (int i = 0; i < NKP; ++i) rk[i] = *(const u32x4*)((const char*)(kd + (size_t)(Rc + i * (4096 / DK)) * 1024 + h * DK) + ko);
#pragma unroll
        for (int i = 0; i < NKP; ++i) { const int p_ = tid + i * 512, row_ = p_ / (DK / 8), c8_ = p_ % (DK / 8); *(LAS u32x4*)(lds + XSB + (row_ * KP + c8_ * 8) * 2) = rk[i]; }
        LBAR();
    }
    MX_LOAD(0);
    for (int jb = 0; jb <= rb; ++jb) {
        f32x4 s = {0.f, 0.f, 0.f, 0.f};
        const LAS unsigned char* kp = lds + XSB + ((jb * 16 + fr) * KP + fq * 8) * 2;
#pragma unroll
        for (int kk = 0; kk < NKK; ++kk) s = mfma16(qf[kk], *(const LAS bf16x8*)(kp + kk * 64), s);
#pragma unroll
        for (int j = 0; j < 4; ++j) { float v = s[j]; if (jb == rb && fr > 4 * fq + j) v = 0.f; xs[(4 * fq + j) * 136 + jb * 16 + fr] = f2bf(v); }
    }
    if ((rb & 1) == 0) {
#pragma unroll
        for (int j = 0; j < 4; ++j) xs[(4 * fq + j) * 136 + (rb + 1) * 16 + fr] = 0;
    }
    const int nks = (rb >> 1) + 1;
    LBAR();
    MX_WRITE(0); MX_LOAD(1);
    LBAR();
    f32x4 acc[NSLAB * 4];
    float ssq[4] = {0.f, 0.f, 0.f, 0.f};
#pragma unroll
    for (int s_ = 0; s_ < NSLAB; ++s_) {
        const LAS unsigned char* sb = lds + XSB + (s_ & 1) * SLABB;
#pragma unroll
        for (int vb = 0; vb < 4; ++vb) {
            f32x4 o = {0.f, 0.f, 0.f, 0.f};
#pragma unroll
            for (int kk = 0; kk < 4; ++kk) if (kk < nks) o = mfma16(*(const LAS bf16x8*)(xs + fr * 136 + kk * 32 + fq * 8), *(const LAS bf16x8*)(sb + SPB + ((vb * 16 + fr) * 136 + kk * 32 + fq * 8) * 2), o);
#pragma unroll
            for (int k4 = 0; k4 < NKK; k4 += 4) { bf16x8 pf[4];
#pragma unroll
                for (int kk = 0; kk < 4; ++kk) pf[kk] = *(const LAS bf16x8*)(sb + ((vb * 16 + fr) * KP + (k4 + kk) * 32 + fq * 8) * 2);
#pragma unroll
                for (int kk = 0; kk < 4; ++kk) o = mfma16(qf[k4 + kk], pf[kk], o); }
            acc[s_ * 4 + vb] = o;
#pragma unroll
            for (int j = 0; j < 4; ++j) ssq[j] += o[j] * o[j];
        }
        if (s_ + 1 < NSLAB) { MX_WRITE((s_ + 1) & 1); if (s_ + 2 < NSLAB) MX_LOAD(s_ + 2); }
        LBAR();
    }
#undef MX_LOAD
#undef MX_WRITE
    float rstd[4];
#pragma unroll
    for (int j = 0; j < 4; ++j) { float s = ssq[j]; s += __shfl_xor(s, 1); s += __shfl_xor(s, 2); s += __shfl_xor(s, 4); s += __shfl_xor(s, 8); rstd[j] = rsqrtf(s * (1.f / DV) + EPS); }
    constexpr int ZP = DV + 8, NRW = DV / 512 > 0 ? DV / 512 : 1;
    LAS bf16_t* zt = (LAS bf16_t*)(lds + wave * 17408);
    const bf16_t* zg = (LAYER == 0 ? ZA0 : Z1) + (size_t)R0 * 2048 + h * DV;
    if (DV == 512) {
#pragma unroll
        for (int i = 0; i < 16; ++i) *(LAS u32x4*)(zt + i * ZP + lane * 8) = *(const u32x4*)(zg + (size_t)i * 2048 + lane * 8);
    } else {
#pragma unroll
        for (int i = 0; i < 8; ++i) { const int row = 2 * i + (lane >> 5), c8 = lane & 31; *(LAS u32x4*)(zt + row * ZP + c8 * 8) = *(const u32x4*)(zg + (size_t)row * 2048 + c8 * 8); }
    }
    LDS_FENCE();
    const float* nw = (LAYER == 0 ? C.ret_norm_w : C.gla_norm_w) + h * DV + fr;
#pragma unroll
    for (int vb = 0; vb < NSLAB * 4; ++vb) {
        const float w = nw[vb * 16];
#pragma unroll
        for (int j = 0; j < 4; ++j) { LAS bf16_t* e = zt + (4 * fq + j) * ZP + vb * 16 + fr; const float z = bf2f(*e); *e = f2bf(acc[vb][j] * rstd[j] * w * siluf_(z)); }
    }
    LDS_FENCE();
    bf16_t* yg = (LAYER == 0 ? YCAT : Y1) + (size_t)R0 * YLD + h * DV;
    if (DV == 512) {
#pragma unroll
        for (int i = 0; i < 16; ++i) *(u32x4*)(yg + (size_t)i * YLD + lane * 8) = *(const LAS u32x4*)(zt + i * ZP + lane * 8);
    } else {
#pragma unroll
        for (int i = 0; i < 8; ++i) { const int row = 2 * i + (lane >> 5), c8 = lane & 31; *(u32x4*)(yg + (size_t)row * YLD + c8 * 8) = *(const LAS u32x4*)(zt + row * ZP + c8 * 8); }
    }
    LBAR();
}

__device__ __forceinline__ void phase1(const Ctx& C, LAS unsigned char* lds, int tid, int lane, int wave, int bid, int G, int rep) {
    const int gw = wave * G + bid, NGW = G * 8; LAS bf16_t* xs = (LAS bf16_t*)(lds + wave * 16384); LAS int* slot = (LAS int*)(lds + 163776); (void)gw; (void)NGW; (void)xs; (void)slot;
        pg8::Gemm g{A0, W1T, 2048, 2048, 2048}; pg8::StaticOrder S; S.init(8192, 8192, G, bid);
        pg8::EpiProj<0> E{C};
        pg8::gemm_phase(lds, g, S, E);
        for (int t = bid; t < 512; t += G) {
            const f32x4 acc = skinny16_wg(A0 + (size_t)PADR * 2048, 2048, W1T + (size_t)t * 16 * 2048, 2048, 2048, lds, wave, lane);
            if (wave != 0) continue;
            bf16_t* dst; int ld, cc; pg8::route(C, 0, t * 16, dst, ld, cc);
#pragma unroll
            for (int j = 0; j < 4; ++j) { const int R = PADR + 4 * (lane >> 4) + j; const bf16_t v = f2bf(acc[j]); dst[(size_t)R * ld + cc + (lane & 15)] = v; dst[(size_t)(R + LP) * ld + cc + (lane & 15)] = v; }
        }
}

__device__ __forceinline__ void phase2(const Ctx& C, LAS unsigned char* lds, int tid, int lane, int wave, int bid, int G, int rep) {
    const int gw = wave * G + bid, NGW = G * 8; LAS bf16_t* xs = (LAS bf16_t*)(lds + wave * 16384); LAS int* slot = (LAS int*)(lds + 163776); (void)gw; (void)NGW; (void)xs; (void)slot;
        for (;;) { __syncthreads(); if (tid == 0) *slot = (int)atomicAdd(CTR + 0 + 8 * rep, 1u); __syncthreads(); const int it = *slot; if (it >= 2 * NCH * 6) break; prep_item<0>(C, it, tid, lds); }
        for (;;) { const int tb = wave_fetch_n(CTR + 1 + 8 * rep, 2u, lane); if (tb >= 2 * 64 * NCH) break; for (int t = tb; t < tb + 2 && t < 2 * 64 * NCH; ++t) s5_task<false>(C, t, lane, xs); }
}

__device__ __forceinline__ void phase3(const Ctx& C, LAS unsigned char* lds, int tid, int lane, int wave, int bid, int G, int rep) {
    const int gw = wave * G + bid, NGW = G * 8; LAS bf16_t* xs = (LAS bf16_t*)(lds + wave * 16384); LAS int* slot = (LAS int*)(lds + 163776); (void)gw; (void)NGW; (void)xs; (void)slot;
        constexpr int NK = 512, NS = 2 * 64 * NCH, NW3 = 32 * 193;
        for (;;) { const int t = block_fetch(CTR + 7 + 8 * rep, slot, tid); if (t >= 128) break; kvscan_wg<0>(C, t, lds, tid, lane, wave); }
        for (;;) { const int tb = wave_fetch_n(CTR + 2 + 8 * rep, 2u, lane); if (tb >= NS) break;
            for (int t = tb; t < tb + 2 && t < NS; ++t) s5_task<true>(C, t, lane, xs); }
        for (;;) { const int tb = wave_fetch_n(CTR + 16 + 8 * rep, 3u, lane); if (tb >= NW3) break;
            for (int t = tb; t < tb + 3 && t < NW3; ++t) transpose_item(C.w_in_c, 2048, 6160, W3T, (LAS float*)xs, t, lane); }
}

__device__ __forceinline__ void phase4(const Ctx& C, LAS unsigned char* lds, int tid, int lane, int wave, int bid, int G, int rep) {
    const int gw = wave * G + bid, NGW = G * 8; LAS bf16_t* xs = (LAS bf16_t*)(lds + wave * 16384); LAS int* slot = (LAS int*)(lds + 163776); (void)gw; (void)NGW; (void)xs; (void)slot;
        pg8::Gemm g{YG, WGLUT, 1024, 1024, 1024}; pg8::SubOrder S{4, bid, 128};
        pg8::EpiGLU E{C};
        pg8::gemm_phase(lds, g, S, E);
        for (int t = bid; t < 64; t += G) {
            {
                const f32x4 acc = skinny16_wg(YG + (size_t)PADR * 1024, 1024, WGLUT + (size_t)t * 16 * 1024, 1024, 1024, lds, wave, lane);
                if (wave != 0) continue;
#pragma unroll
                for (int j = 0; j < 4; ++j) { const int R = PADR + 4 * (lane >> 4) + j, col = t * 16 + (lane & 15);
                    const float y = bf2f(YG[(size_t)R * 1024 + col]), z = bf2f(ZB0[(size_t)R * 1024 + col]); const bf16_t o = f2bf(y * sigmoidf_(acc[j]) * siluf_(z));
                    YCAT[(size_t)R * 3072 + 2048 + col] = o; YCAT[(size_t)(R + LP) * 3072 + 2048 + col] = o; }
            }
        }
        for (;;) { const int t = block_fetch(CTR + 3 + 8 * rep, slot, tid); if (t >= 16 * NCH) break; mixout_wg<0>(C, t, lds, tid, lane, wave); }
}

__device__ __forceinline__ void phase6(const Ctx& C, LAS unsigned char* lds, int tid, int lane, int wave, int bid, int G, int rep) {
    const int gw = wave * G + bid, NGW = G * 8; LAS bf16_t* xs = (LAS bf16_t*)(lds + wave * 16384); LAS int* slot = (LAS int*)(lds + 163776); (void)gw; (void)NGW; (void)xs; (void)slot;
        pg8::Gemm g{A1, W3T, 2048, 2048, 2048}; pg8::StaticOrder S; S.init(8192, 6144, G, bid);
        pg8::EpiProj<1> E{C};
        pg8::gemm_phase(lds, g, S, E);
        for (int t = bid; t < 514 + 192; t += G) {
            if (t < 514) {
                const int b = t / 257, Rb = b * LP + PADR + (t % 257) * 16;
                const f32x4 acc = skinny16_wg(A1 + (size_t)Rb * 2048, 2048, W3T + (size_t)6144 * 2048, 2048, 2048, lds, wave, lane);
                if (wave != 0) continue;
#pragma unroll
                for (int j = 0; j < 4; ++j) { const int R = Rb + 4 * (lane >> 4) + j; GLOW[(size_t)R * 16 + (lane & 15)] = acc[j] * rsqrtf(SSQ1[R] * (1.f / 2048.f) + EPS); }
            } else {
                const int c3 = 1024 + (t - 514) * 16;
                const f32x4 acc = skinny16_wg(A1 + (size_t)PADR * 2048, 2048, W3T + (size_t)c3 * 2048, 2048, 2048, lds, wave, lane);
                if (wave != 0) continue;
                bf16_t* dst; int ld, cc; pg8::route(C, 1, c3, dst, ld, cc);
#pragma unroll
                for (int j = 0; j < 4; ++j) { const int R = PADR + 4 * (lane >> 4) + j; const bf16_t v = f2bf(acc[j] * rsqrtf(SSQ1[R] * (1.f / 2048.f) + EPS));
                    dst[(size_t)R * ld + cc + (lane & 15)] = v; dst[(size_t)(R + LP) * ld + cc + (lane & 15)] = v; }
            }
        }
}

__device__ __forceinline__ void phase7(const Ctx& C, LAS unsigned char* lds, int tid, int lane, int wave, int bid, int G, int rep) {
    const int gw = wave * G + bid, NGW = G * 8; LAS bf16_t* xs = (LAS bf16_t*)(lds + wave * 16384); LAS int* slot = (LAS int*)(lds + 163776); (void)gw; (void)NGW; (void)xs; (void)slot;
        for (;;) { __syncthreads(); if (tid == 0) *slot = (int)atomicAdd(CTR + 4 + 8 * rep, 1u); __syncthreads(); const int it = *slot; if (it >= 2 * NCH * 6) break; prep_item<1>(C, it, tid, lds); }
}

#define XB_TMO      128
#define XB_XCNT(j)  (256  + 64 * (j))
#define XB_XSUB(j)  (1280 + 64 * (j))
#define XB_XGEN(j)  (2304 + 64 * (j))
#define XB_TOP      3328
#define XB_TOPGEN   3392
#define XCD_BAR_WORDS 3456
#define XB_SPIN_CAP (1u << 22)
constexpr size_t M_BAR = 7340032;
__device__ __forceinline__ unsigned xb_ld(unsigned* p)              { return __hip_atomic_load(p, __ATOMIC_RELAXED, __HIP_MEMORY_SCOPE_AGENT); }
__device__ __forceinline__ unsigned xb_add(unsigned* p, unsigned v) { return __hip_atomic_fetch_add(p, v, __ATOMIC_RELAXED, __HIP_MEMORY_SCOPE_AGENT); }
__device__ __forceinline__ unsigned xb_xcc_id() { return (unsigned)__builtin_amdgcn_s_getreg((3 << 11) | 20) & 0xFu; }
#define XB_SPIN(cond, bar) do { unsigned _sp = 0; while (cond) { __builtin_amdgcn_s_sleep(1); \
    if ((++_sp & 255u) == 0u) { if (xb_ld(&(bar)[XB_TMO])) break; if (_sp > XB_SPIN_CAP) { atomicAdd(&(bar)[XB_TMO], 1u); break; } } } } while (0)
struct XcdBarrier { unsigned* bar; unsigned x; volatile LAS unsigned* st; };
__device__ __forceinline__ XcdBarrier xcd_barrier_post(unsigned* bar, volatile LAS unsigned* st) {
    XcdBarrier b; b.bar = bar; b.x = xb_xcc_id(); b.st = st;
    if (threadIdx.x == 0) (void)xb_add(&bar[XB_XCNT(b.x)], 1u);
    return b;
}
__device__ __forceinline__ void xcd_barrier_complete(unsigned* bar, unsigned x, unsigned& nloc, unsigned& nx) {
    const unsigned G = gridDim.x * gridDim.y * gridDim.z;
    unsigned sum, cnt, mine, sp = 0u;
    for (;;) {
        sum = 0u; cnt = 0u; mine = 0u;
#pragma unroll
        for (unsigned j = 0; j < 16; ++j) { const unsigned c = xb_ld(&bar[XB_XCNT(j)]); sum += c; cnt += (c > 0u) ? 1u : 0u; mine = (j == x) ? c : mine; }
        if (sum == G) break;
        __builtin_amdgcn_s_sleep(1);
        if ((++sp & 255u) == 0u) { if (xb_ld(&bar[XB_TMO])) break; if (sp > XB_SPIN_CAP) { atomicAdd(&bar[XB_TMO], 1u); break; } }
    }
    nloc = mine > 0u ? mine : 1u; nx = cnt > 0u ? cnt : 1u;
}
__device__ __forceinline__ void xcd_barrier(const XcdBarrier& b) {
    asm volatile("s_waitcnt vmcnt(0)" ::: "memory");
    __syncthreads();
    if (threadIdx.x == 0) {
        unsigned* bar = b.bar;
        __builtin_amdgcn_s_waitcnt(0);
        unsigned nloc = b.st[0], nx = b.st[1];
        if (nloc == 0u) { xcd_barrier_complete(bar, b.x, nloc, nx); b.st[0] = nloc; b.st[1] = nx; }
        const unsigned old = xb_add(&bar[XB_XSUB(b.x)], 1u);
        const unsigned gen = old / nloc;
        if (old + 1u == (gen + 1u) * nloc) {
            __builtin_amdgcn_fence(__ATOMIC_RELEASE, "agent");
            asm volatile("s_waitcnt vmcnt(0)" ::: "memory");
            const unsigned og = xb_add(&bar[XB_TOP], 1u);
            const unsigned tg = og / nx;
            if (og + 1u == (tg + 1u) * nx) xb_add(&bar[XB_TOPGEN], 1u);
            else XB_SPIN(xb_ld(&bar[XB_TOPGEN]) == tg, bar);
            __builtin_amdgcn_fence(__ATOMIC_ACQUIRE, "agent");
            xb_add(&bar[XB_XGEN(b.x)], 1u);
            asm volatile("s_waitcnt vmcnt(0)" ::: "memory");
        } else {
            XB_SPIN(xb_ld(&bar[XB_XGEN(b.x)]) == gen, bar);
            __builtin_amdgcn_fence(__ATOMIC_ACQUIRE, "agent");
            asm volatile("s_waitcnt vmcnt(0)" ::: "memory");
        }
    }
    __syncthreads();
}

__global__ void __launch_bounds__(512, 2) fwd(Ctx C) {
    extern __shared__ __attribute__((aligned(16))) unsigned char lds_raw[];
    LAS unsigned char* lds = (LAS unsigned char*)lds_raw;
    cg::grid_group grid = cg::this_grid();
    const int tid = threadIdx.x, lane = tid & 63, wave = __builtin_amdgcn_readfirstlane(tid >> 6), bid = blockIdx.x, G = gridDim.x;
    const int gw = wave * G + bid, NGW = G * 8;
    LAS bf16_t* xs = (LAS bf16_t*)(lds + wave * 16384);
    LAS int* slot = (LAS int*)(lds + 163776);
    const int lo = C.ph_lo, hi = C.ph_hi;
#define IN(k) (lo <= (k) && (k) < hi)
#define REPK(k) ((REP_MASK >> (k)) & 1)
#define REPLOOP(k) for (int rep = 0; rep <= REPK(k); ++rep)
#define REPSYNC(k) do { if (rep < REPK(k)) grid.sync(); } while (0)
#ifdef PROBE_A
    unsigned long long* STAMP = (unsigned long long*)WSB(MISC + 7000000);
#define STAMPIT(k) do { if (bid == 0 && tid == 0) STAMP[k] = __builtin_amdgcn_s_memrealtime(); } while (0)
#else
#define STAMPIT(k) do {} while (0)
#endif
    volatile LAS unsigned* bst = (volatile LAS unsigned*)(lds + 163792);
    if (tid < 2) bst[tid] = 0u;
    __syncthreads();
    XcdBarrier xbar = xcd_barrier_post((unsigned*)WSB(MISC + M_BAR), bst);
    if (C.ph_hi > 1000) grid.sync();
#define SEAM(k) do { if (IN(k) && IN((k) + 1)) xcd_barrier(xbar); STAMPIT((k) + 1); } while (0)
    STAMPIT(0);

    if (IN(0)) { p0_phase(C, lds, tid, lane, wave, bid, G); if (REPK(0)) { xcd_barrier(xbar); p0_phase(C, lds, tid, lane, wave, bid, G); } }
    SEAM(0);
    if (IN(1)) { phase1(C, lds, tid, lane, wave, bid, G, 0); if (REPK(1)) { xcd_barrier(xbar); phase1(C, lds, tid, lane, wave, bid, G, 1); } }
    SEAM(1);
    if (IN(2)) { phase2(C, lds, tid, lane, wave, bid, G, 0); if (REPK(2)) { xcd_barrier(xbar); phase2(C, lds, tid, lane, wave, bid, G, 1); } }
    SEAM(2);
    if (IN(3)) { phase3(C, lds, tid, lane, wave, bid, G, 0); if (REPK(3)) { xcd_barrier(xbar); phase3(C, lds, tid, lane, wave, bid, G, 1); } }
    SEAM(3);
    if (IN(4)) { phase4(C, lds, tid, lane, wave, bid, G, 0); if (REPK(4)) { xcd_barrier(xbar); phase4(C, lds, tid, lane, wave, bid, G, 1); } }
    SEAM(4);
    if (IN(5)) {
        pg8::Gemm g{YCAT, WO1T, 3072, 3072, 3072}; pg8::StaticOrder S; S.init(8192, 2048, G, bid);
        pg8::EpiOut<0> E{C};
        pg8::gemm_phase(lds, g, S, E);
        for (int t = bid; t < 128; t += G) {
            const f32x4 acc = skinny16_wg(YCAT + (size_t)PADR * 3072, 3072, WO1T + (size_t)t * 16 * 3072, 3072, 3072, lds, wave, lane);
            if (wave != 0) continue;
            const int col = t * 16 + (lane & 15); const float w = C.norm_c_w[col];
#pragma unroll
            for (int j = 0; j < 4; ++j) { const int mr = 4 * (lane >> 4) + j; const float hv = C.meta[(size_t)mr * DM + col] + acc[j];
                const bf16_t o = f2bf(hv * w); A1[(size_t)(PADR + mr) * DM + col] = o; A1[(size_t)(LP + PADR + mr) * DM + col] = o;
                float s = hv * hv; s += __shfl_xor(s, 1); s += __shfl_xor(s, 2); s += __shfl_xor(s, 4); s += __shfl_xor(s, 8);
                if ((lane & 15) == 0) { unsafeAtomicAdd(SSQ1 + PADR + mr, s); unsafeAtomicAdd(SSQ1 + LP + PADR + mr, s); } }
        }
    }
    SEAM(5);
    if (IN(6)) { phase6(C, lds, tid, lane, wave, bid, G, 0); if (REPK(6)) { xcd_barrier(xbar); phase6(C, lds, tid, lane, wave, bid, G, 1); } }
    SEAM(6);
    if (IN(7)) { phase7(C, lds, tid, lane, wave, bid, G, 0); if (REPK(7)) { xcd_barrier(xbar); phase7(C, lds, tid, lane, wave, bid, G, 1); } }
    SEAM(7);
    if (IN(8)) { for (;;) { const int t = block_fetch(CTR + 5, slot, tid); if (t >= 128) break; kvscan_wg<1>(C, t, lds, tid, lane, wave); } if (REPK(8)) { xcd_barrier(xbar); for (;;) { const int t = block_fetch(CTR + 13, slot, tid); if (t >= 128) break; kvscan_wg<1>(C, t, lds, tid, lane, wave); } } }
    SEAM(8);
    if (IN(9)) { for (;;) { const int t = block_fetch(CTR + 6, slot, tid); if (t >= 8 * 32) break; mixout_wg<1>(C, t, lds, tid, lane, wave); } if (REPK(9)) { xcd_barrier(xbar); for (;;) { const int t = block_fetch(CTR + 14, slot, tid); if (t >= 8 * 32) break; mixout_wg<1>(C, t, lds, tid, lane, wave); } } }
    SEAM(9);
    if (IN(10)) {
        pg8::Gemm g{Y1, WO2T, 2048, 2048, 2048}; pg8::StaticOrder S; S.init(8192, 2048, G, bid);
        pg8::EpiOut<1> E{C};
        pg8::gemm_phase(lds, g, S, E);
    }
    SEAM(10);
#ifdef EXTRA_SYNCS
    for (int q = 0; q < EXTRA_SYNCS; ++q) grid.sync();
#endif
    if (IN(11)) {
        for (int r = gw; r < 8192; r += NGW) {
            const float rstd = rsqrtf(SSQ2[r] * (1.f / 2048.f) + EPS);
            float* row = C.out + (size_t)r * DM;
#pragma unroll
            for (int j = 0; j < 8; ++j) { const int c = (lane + 64 * j) * 4; const f32x4 v = *(const f32x4*)(row + c), w = *(const f32x4*)(C.final_w + c); *(f32x4*)(row + c) = v * rstd * w; }
        }
    }
#ifdef PROBE_A
    grid.sync();
    if (bid == 0) {
        if (tid == 0) STAMP[12] = __builtin_amdgcn_s_memrealtime();
        __syncthreads();
        const float da = (float)(STAMP[PROBE_A + 1] - STAMP[PROBE_A]) * 0.01f, db = (float)(STAMP[PROBE_B + 1] - STAMP[PROBE_B]) * 0.01f;
        if (tid == 0) C.out[0] = da;
        for (int i = 1048576 + tid; i < 2097152; i += 512) C.out[i] += db * 0.01f;
    }
#endif
#undef IN
#undef SEAM
}

__global__ void dump_k(const bf16_t* src, float* out, int n) { for (int i = blockIdx.x * blockDim.x + threadIdx.x; i < n; i += gridDim.x * blockDim.x) { if (i < 8650752) { const int row = i / 2048; out[i] = (row >= 128 && row < 4096) ? bf2f(src[(size_t)row * 3072 + (i % 2048)]) : 0.f; } } }
extern "C" void kernel_launch(void* const* d_in, const int* in_sizes, int n_in, void* d_out, int out_size, void* d_ws, size_t ws_size, hipStream_t stream) {
    static int ready = 0;
    if (!ready) {
        if (hipFuncSetAttribute((const void*)fwd, hipFuncAttributeMaxDynamicSharedMemorySize, LDS_BYTES) != hipSuccess) fprintf(stderr, "kernel_launch: hipFuncSetAttribute failed\n");
        ready = 1;
    }
    Ctx c{};
    const float** p = (const float**)&c;
    for (int i = 0; i < 22; ++i) p[i] = (const float*)d_in[i];
    c.out = (float*)d_out; c.ws = (unsigned char*)d_ws;
#ifdef MK_MULTI
    hipMemsetAsync(d_ws, 0, 268435456, stream); hipMemsetAsync(d_out, 0, (size_t)out_size * 4, stream);
    for (int ph = 0; ph < RUN_PH; ++ph) { c.ph_lo = ph; c.ph_hi = ph + 1; hipLaunchKernelGGL(fwd, dim3(256), dim3(512), LDS_BYTES, stream, c); }
#ifdef DUMP_SLOT
    hipLaunchKernelGGL(dump_k, dim3(2048), dim3(256), 0, stream, (const bf16_t*)((unsigned char*)d_ws + (size_t)DUMP_SLOT * SLOT), (float*)d_out, out_size);
#endif
#else
    c.ph_lo = 0; c.ph_hi = NPHASE;
    (void)hipMemsetAsync((unsigned char*)d_ws + MISC + M_BAR, 0, 16384, stream);
    void* args[] = {&c};
    hipError_t e = hipLaunchCooperativeKernel((const void*)fwd, dim3(256), dim3(512), args, LDS_BYTES, stream);
    if (e != hipSuccess) fprintf(stderr, "cooperative launch failed: %s\n", hipGetErrorString(e));
#endif
}
```

```cpp
#define RUN_PH NPHASE
#define REP_MASK 0
#define DBG_INTER 1
#define DBG_NORM 1
#include <hip/hip_runtime.h>
#include <hip/hip_cooperative_groups.h>
#include <cstdio>
#include <cstdint>
namespace cg = cooperative_groups;

#define LAS __attribute__((address_space(3)))
typedef unsigned short bf16_t;
typedef short bf16x8 __attribute__((ext_vector_type(8)));
typedef float f32x4 __attribute__((ext_vector_type(4)));
typedef float f32x2 __attribute__((ext_vector_type(2)));
typedef unsigned u32x4 __attribute__((ext_vector_type(4)));
typedef unsigned u32x2 __attribute__((ext_vector_type(2)));

constexpr int DM = 2048, SEQ = 4096, LP = 4224, NR = 2 * LP, NCH = 33, PADR = 112;
constexpr float EPS = 1e-6f;
constexpr size_t SLOT = (size_t)NR * 1024 * 2;
constexpr size_t MISC = 15 * SLOT;
constexpr size_t M_CTR = 0, M_SSQ1 = 1024, M_SSQ2 = 34816, M_ROPE = 131072, M_S5AB = 2359296, M_S5A128 = M_S5AB + 32768,
                 M_S5BB = 2424832, M_S5C = 2949120, M_S5E = 3211264, M_DEC1 = 5373952, M_GLOW = 5644288, M_S5BBT = 6184960;
constexpr int LDS_BYTES = 163840;
constexpr int NPHASE = 12;

struct Ctx {
    const float *x, *meta, *norm_ab_w, *w_in_ab, *ret_norm_w, *lam_re, *lam_im, *log_dt, *b_re, *b_im, *c_re, *c_im, *s5d, *w_glu, *w_out_ab,
        *norm_c_w, *w_in_c, *w_gate, *b_gate, *gla_norm_w, *w_out_c, *final_w;
    float* out; unsigned char* ws; int ph_lo, ph_hi;
};

#define WSB(off) (C.ws + (off))
#define SL(i) ((bf16_t*)(C.ws + (size_t)(i) * SLOT))
#define W1T SL(0)
#define WO1T SL(2)
#define U0 SL(3)
#define Q0RAW SL(4)
#define K0RAW SL(5)
#define V0RAW SL(6)
#define ZA0 SL(8)
#define ZB0 SL(10)
#define WGLUT SL(11)
#define WO2T ((bf16_t*)(C.ws + 11 * SLOT + 2097152))
#define KD0 SL(12)
#define KT0 SL(13)
#define YG SL(14)
#define A0 ((bf16_t*)C.out)
#define VT0 ((bf16_t*)C.out)
#define QD0 ((bf16_t*)((unsigned char*)C.out + 2 * SLOT))
#define SP0 SL(0)
#define YCAT SL(3)
#define W3T SL(6)
#define A1 SL(0)
#define Q1RAW SL(3)
#define K1RAW SL(4)
#define V1RAW SL(8)
#define Z1 SL(12)
#define QD1 SL(5)
#define KD1 SL(10)
#define KT1 SL(14)
#define VT1 SL(0)
#define SP1 SL(6)
#define Y1 SL(3)
#define CTR ((unsigned*)WSB(MISC + M_CTR))
#define SSQ1 ((float*)WSB(MISC + M_SSQ1))
#define SSQ2 ((float*)WSB(MISC + M_SSQ2))
#define ROPE ((f32x2*)WSB(MISC + M_ROPE))
#define S5AB ((f32x2*)WSB(MISC + M_S5AB))
#define S5A128 ((f32x2*)WSB(MISC + M_S5A128))
#define S5BB ((float*)WSB(MISC + M_S5BB))
#define S5C ((bf16_t*)WSB(MISC + M_S5C))
#define S5E ((float*)WSB(MISC + M_S5E))
#define DEC1 ((float*)WSB(MISC + M_DEC1))
#define GLOW ((float*)WSB(MISC + M_GLOW))
#define S5BBT ((bf16_t*)WSB(MISC + M_S5BBT))

#define LDS_FENCE() asm volatile("s_waitcnt lgkmcnt(0)" ::: "memory")
#define LBAR() do { asm volatile("s_waitcnt lgkmcnt(0)" ::: "memory"); __builtin_amdgcn_s_barrier(); asm volatile("" ::: "memory"); } while (0)
typedef __bf16 bf16v2_t __attribute__((ext_vector_type(2)));
__device__ __forceinline__ unsigned cvt_pk_bf16(float lo, float hi) { bf16v2_t v; v.x = (__bf16)lo; v.y = (__bf16)hi; return __builtin_bit_cast(unsigned, v); }
__device__ __forceinline__ bf16_t f2bf(float f) { return (bf16_t)(cvt_pk_bf16(f, 0.f) & 0xffffu); }
__device__ __forceinline__ float bf2f(bf16_t h) { return __uint_as_float(((unsigned)h) << 16); }
__device__ __forceinline__ float bflo(unsigned w) { return __uint_as_float(w << 16); }
__device__ __forceinline__ float bfhi(unsigned w) { return __uint_as_float(w & 0xffff0000u); }
__device__ __forceinline__ float wave_sum(float v) {
#pragma unroll
    for (int o = 1; o < 64; o <<= 1) v += __shfl_xor(v, o);
    return v;
}
__device__ __forceinline__ float sigmoidf_(float x) { return 1.f / (1.f + __expf(-x)); }
__device__ __forceinline__ float siluf_(float x) { return x / (1.f + __expf(-x)); }
__device__ __forceinline__ float gelu_tanh(float x) { const float t = 0.7978845608028654f * (x + 0.044715f * x * x * x); const float th = 1.f - 2.f / (__expf(2.f * t) + 1.f); return 0.5f * x * (1.f + th); }
__device__ __forceinline__ f32x4 mfma16(bf16x8 a, bf16x8 b, f32x4 c) { return __builtin_amdgcn_mfma_f32_16x16x32_bf16(a, b, c, 0, 0, 0); }
__device__ __forceinline__ void gstore16_hidden(void* p, u32x4 v) { asm volatile("global_store_dwordx4 %0, %1, off" :: "v"(p), "v"(v) : "memory"); }
__device__ __forceinline__ void gstore8_hidden(void* p, u32x2 v) { asm volatile("global_store_dwordx2 %0, %1, off" :: "v"(p), "v"(v) : "memory"); }
__device__ __forceinline__ int wave_fetch_n(unsigned* ctr, unsigned nb, int lane) { unsigned v = 0; if (lane == 0) v = atomicAdd(ctr, nb); return (int)__builtin_amdgcn_readfirstlane(v); }
__device__ __forceinline__ int wave_fetch(unsigned* ctr, int lane) { unsigned v = 0; if (lane == 0) v = atomicAdd(ctr, 1u); return (int)__builtin_amdgcn_readfirstlane(v); }
__device__ __forceinline__ void dsincos(double x, double& s, double& c) {
    const double q = rint(x * 0.6366197723675814);
    double r = fma(-q, 1.5707963267948966, x); r = fma(-q, 6.123233995736766e-17, r);
    const int iq = ((int)q) & 3; const double r2 = r * r;
    const double sp = r * (1.0 + r2 * (-1.0 / 6 + r2 * (1.0 / 120 + r2 * (-1.0 / 5040 + r2 * (1.0 / 362880 + r2 * (-1.0 / 39916800 + r2 * (1.0 / 6227020800.0)))))));
    const double cp = 1.0 + r2 * (-0.5 + r2 * (1.0 / 24 + r2 * (-1.0 / 720 + r2 * (1.0 / 40320 + r2 * (-1.0 / 3628800 + r2 * (1.0 / 479001600.0 + r2 * (-1.0 / 87178291200.0)))))));
    s = (iq == 0) ? sp : (iq == 1) ? cp : (iq == 2) ? -sp : -cp;
    c = (iq == 0) ? cp : (iq == 1) ? -sp : (iq == 2) ? -cp : sp;
}

namespace pg8 {
constexpr int BM = 256, BK = 64, HALF = 128, HTB = HALF * BK * 2, STAGE_BYTES = 8 * HTB, NXCD = 8, WGM = 8;
__host__ __device__ __forceinline__ int lds_byte(int r, int c) { const int st = (r >> 4) * 2 + (c >> 5), rr = r & 15, cc = c & 31, ob = rr * 64 + cc * 2; return st * 1024 + (ob ^ (((ob >> 9) & 1) << 5)); }
__host__ __device__ __forceinline__ void stage_rc(int b, int& R, int& Cc) { const int st = b / 1024, sb = b % 1024, swz = sb ^ (((sb >> 9) & 1) << 5); R = (st >> 1) * 16 + swz / 64; Cc = (st & 1) * 32 + (swz % 64) / 2; }
__host__ __device__ __forceinline__ int perm32(int rho) { const int n = rho >> 4, i = rho & 15; return 8 * (i >> 2) + 4 * n + (i & 3); }
struct Unit { int pm, pn; };
struct Gemm { const bf16_t* A; const bf16_t* Bt; int lda, ldb, K; };
__device__ __forceinline__ int arow(int pm) { return (pm >> 4) * LP + 128 + (pm & 15) * 256; }
struct StaticOrder {
    int nM, nN, nwg, G, c;
    __device__ void init(int M, int N, int G_, int c_) { nM = M / BM; nN = N / BM; nwg = nM * nN; G = G_; c = c_; }
    __device__ bool next(int i, Unit& u) const {
        const long L = (long)i * G + c; if (L >= nwg) return false;
        int wgid = (int)L; { const int q = nwg / NXCD, r = nwg % NXCD, xcd = wgid % NXCD, off = wgid / NXCD; wgid = (xcd < r ? xcd * (q + 1) : r * (q + 1) + (xcd - r) * q) + off; }
        const int nig = WGM * nN, gid = wgid / nig, fm = gid * WGM, gsz = (nM - fm) < WGM ? (nM - fm) : WGM;
        u.pm = fm + ((wgid % nig) % gsz); u.pn = (wgid % nig) / gsz; return true;
    }
};
struct SubOrder {
    int nN, c, nunits;
    __device__ bool next(int i, Unit& u) const { if (i > 0 || c >= nunits) return false; u.pm = c / nN; u.pn = c % nN; return true; }
};

template <class Epi, class Sched>
__device__ __forceinline__ void gemm_phase(LAS unsigned char* lds, const Gemm g, const Sched& S, const Epi& E) {
    const int tid = threadIdx.x, wid = __builtin_amdgcn_readfirstlane(tid >> 6), lane = tid & 63, wr = wid >> 2, wc = wid & 3, fr = lane & 15, fq = lane >> 4;
    const int K = g.K, nt = K / BK;
    unsigned voffA[2], voffB[2];
#pragma unroll
    for (int i = 0; i < 2; ++i) { int R, Cc; stage_rc(tid * 16 + i * 8192, R, Cc); const int Rb = (R & ~31) + perm32(R & 31);
        voffA[i] = (unsigned)(R * g.lda + Cc) * 2u; voffB[i] = (unsigned)(Rb * g.ldb + Cc) * 2u; }
    const size_t kstep = (size_t)(BK * 2);
    const size_t hA = (size_t)HALF * g.lda * 2, hB = (size_t)HALF * g.ldb * 2;
    const unsigned ldsw = (unsigned)wid * 1024u;
    const int aoff = lds_byte(wr * 64 + fr, fq * 8), boff = lds_byte(wc * 32 + fr, fq * 8);
#define PG8_SA(b, h) (((b) * 2 + (h)) * HTB)
#define PG8_SB(b, h) ((4 + (b) * 2 + (h)) * HTB)
#define PG8_STAGE(bufoff, gbase, voff) do { _Pragma("unroll") for (int _i = 0; _i < 2; ++_i) \
        __builtin_amdgcn_global_load_lds((const unsigned*)((const char*)(gbase) + (voff)[_i]), (LAS unsigned*)(lds + (bufoff) + ldsw + _i * 8192), 16, 0, 0); } while (0)
#define PG8_LDA(dst, b, h) do { _Pragma("unroll") for (int m = 0; m < 4; ++m) _Pragma("unroll") for (int k = 0; k < 2; ++k) dst[m][k] = *(const LAS bf16x8*)(lds + PG8_SA(b, h) + aoff + m * 2048 + k * 1024); } while (0)
#define PG8_LDB(dst, b, h) do { _Pragma("unroll") for (int n = 0; n < 2; ++n) _Pragma("unroll") for (int k = 0; k < 2; ++k) dst[n][k] = *(const LAS bf16x8*)(lds + PG8_SB(b, h) + boff + n * 2048 + k * 1024); } while (0)
#define PG8_MMA(ai, bj, At, Bt) do { __builtin_amdgcn_s_setprio(1); _Pragma("unroll") for (int m = 0; m < 4; ++m) _Pragma("unroll") for (int n = 0; n < 2; ++n) _Pragma("unroll") for (int k = 0; k < 2; ++k) \
        acc[ai][bj][m][n] = __builtin_amdgcn_mfma_f32_16x16x32_bf16(Bt[n][k], At[m][k], acc[ai][bj][m][n], 0, 0, 0); __builtin_amdgcn_s_setprio(0); } while (0)
#define PG8_WAIT_V(n) asm volatile("s_waitcnt vmcnt(" #n ")" ::: "memory")
#define PG8_WAIT_L(n) asm volatile("s_waitcnt lgkmcnt(" #n ")" ::: "memory")
#define PG8_BAR __builtin_amdgcn_s_barrier()
#define PG8_SCHED __builtin_amdgcn_sched_barrier(0)
    Unit cur, nxt; int ui = 0;
    if (!S.next(0, cur)) return;
    f32x4 acc[2][2][4][2];
#pragma unroll
    for (int a = 0; a < 2; ++a)
#pragma unroll
        for (int b = 0; b < 2; ++b)
#pragma unroll
            for (int m = 0; m < 4; ++m)
#pragma unroll
                for (int n = 0; n < 2; ++n) acc[a][b][m][n] = (f32x4){0.f, 0.f, 0.f, 0.f};
    bf16x8 At[4][2], B0[2][2], B1[2][2];
    const char* cA = (const char*)g.A + (size_t)arow(cur.pm) * g.lda * 2; const char* cB = (const char*)g.Bt + (size_t)cur.pn * 256 * g.ldb * 2;
    PG8_STAGE(PG8_SB(0, 0), cB, voffB); PG8_STAGE(PG8_SB(0, 1), cB + hB, voffB); PG8_STAGE(PG8_SA(0, 0), cA, voffA); PG8_STAGE(PG8_SA(0, 1), cA + hA, voffA);
    if (wr == 1) PG8_BAR;
    PG8_WAIT_V(2); PG8_BAR;
    PG8_STAGE(PG8_SB(1, 0), cB + kstep, voffB); PG8_STAGE(PG8_SA(1, 0), cA + kstep, voffA); PG8_STAGE(PG8_SB(1, 1), cB + hB + kstep, voffB);
    PG8_WAIT_V(6); PG8_BAR;
    for (;;) {
        const bool has_next = S.next(ui + 1, nxt);
        const char* nA = has_next ? (const char*)g.A + (size_t)arow(nxt.pm) * g.lda * 2 : cA; const char* nB = has_next ? (const char*)g.Bt + (size_t)nxt.pn * 256 * g.ldb * 2 : cB;
        for (int t = 0; t < nt; t += 2) {
            const bool last = (t == nt - 2);
            const char* a1 = cA + (size_t)(t + 1) * kstep;
            const char* a2 = last ? nA : cA + (size_t)(t + 2) * kstep; const char* b2 = last ? nB : cB + (size_t)(t + 2) * kstep;
            const char* a3 = a2 + kstep; const char* b3 = b2 + kstep;
            PG8_LDB(B0, 0, 0); PG8_LDB(B1, 0, 1); PG8_SCHED; PG8_LDA(At, 0, 0); PG8_STAGE(PG8_SA(1, 1), a1 + hA, voffA);
            PG8_WAIT_V(8); PG8_WAIT_L(0); PG8_BAR; PG8_MMA(0, 0, At, B0); PG8_MMA(0, 1, At, B1); PG8_BAR; PG8_SCHED;
            PG8_LDA(At, 0, 1); PG8_STAGE(PG8_SB(0, 0), b2, voffB); PG8_STAGE(PG8_SB(0, 1), b2 + hB, voffB); PG8_STAGE(PG8_SA(0, 0), a2, voffA);
            PG8_WAIT_V(8); PG8_WAIT_L(0); PG8_BAR; PG8_MMA(1, 0, At, B0); PG8_MMA(1, 1, At, B1); PG8_BAR; PG8_SCHED;
            PG8_LDB(B0, 1, 0); PG8_LDB(B1, 1, 1); PG8_SCHED; PG8_LDA(At, 1, 0); PG8_STAGE(PG8_SA(0, 1), a2 + hA, voffA);
            PG8_WAIT_V(8); PG8_WAIT_L(0); PG8_BAR; PG8_MMA(0, 0, At, B0); PG8_MMA(0, 1, At, B1); PG8_BAR; PG8_SCHED;
            PG8_LDA(At, 1, 1); PG8_STAGE(PG8_SB(1, 0), b3, voffB); PG8_STAGE(PG8_SB(1, 1), b3 + hB, voffB); PG8_STAGE(PG8_SA(1, 0), a3, voffA);
            PG8_WAIT_V(8); PG8_WAIT_L(0); PG8_BAR; PG8_MMA(1, 0, At, B0); PG8_MMA(1, 1, At, B1); PG8_BAR; PG8_SCHED;
        }
        if (wr == 0) PG8_BAR;
        E(acc, cur, wr, wc, fr, fq);
        if (!has_next) break;
#pragma unroll
        for (int a = 0; a < 2; ++a)
#pragma unroll
            for (int b = 0; b < 2; ++b)
#pragma unroll
                for (int m = 0; m < 4; ++m)
#pragma unroll
                    for (int n = 0; n < 2; ++n) acc[a][b][m][n] = (f32x4){0.f, 0.f, 0.f, 0.f};
        cur = nxt; cA = nA; cB = nB; ++ui;
        if (wr == 1) PG8_BAR;
    }
    PG8_WAIT_V(0);
    PG8_BAR;
#undef PG8_SA
#undef PG8_SB
#undef PG8_STAGE
#undef PG8_LDA
#undef PG8_LDB
#undef PG8_MMA
#undef PG8_WAIT_V
#undef PG8_WAIT_L
#undef PG8_BAR
#undef PG8_SCHED
}
typedef f32x4 Acc[2][2][4][2];

__device__ __forceinline__ void route(const Ctx& C, int layer, int c0, bf16_t*& dst, int& ld, int& cc) {
    if (layer == 0) {
        if (c0 < 1024) { dst = Q0RAW; ld = 1024; cc = c0; } else if (c0 < 2048) { dst = K0RAW; ld = 1024; cc = c0 - 1024; }
        else if (c0 < 4096) { dst = V0RAW; ld = 2048; cc = c0 - 2048; } else if (c0 < 6144) { dst = ZA0; ld = 2048; cc = c0 - 4096; }
        else if (c0 < 7168) { dst = U0; ld = 1024; cc = c0 - 6144; } else { dst = ZB0; ld = 1024; cc = c0 - 7168; }
    } else {
        if (c0 < 1024) { dst = Q1RAW; ld = 1024; cc = c0; } else if (c0 < 2048) { dst = K1RAW; ld = 1024; cc = c0 - 1024; }
        else if (c0 < 4096) { dst = V1RAW; ld = 2048; cc = c0 - 2048; } else { dst = Z1; ld = 2048; cc = c0 - 4096; }
    }
}
template <int LAYER> struct EpiProj {
    Ctx C;
    __device__ __forceinline__ void operator()(const Acc& acc, const Unit& u, int wr, int wc, int fr, int fq) const {
        bf16_t* dst; int ld, c0; route(C, LAYER, u.pn * 256, dst, ld, c0);
        const int rbase = arow(u.pm);
#pragma unroll
        for (int ai = 0; ai < 2; ++ai)
#pragma unroll
            for (int m = 0; m < 4; ++m) {
                const int R = rbase + ai * 128 + wr * 64 + m * 16 + fr;
                float sc = 1.f; if (LAYER == 1) sc = rsqrtf(SSQ1[R] * (1.f / 2048.f) + EPS);
#pragma unroll
                for (int bj = 0; bj < 2; ++bj) {
                    const int cl = c0 + bj * 128 + wc * 32 + 8 * fq; const f32x4 v0 = acc[ai][bj][m][0] * sc, v1 = acc[ai][bj][m][1] * sc;
                    u32x4 w; w.x = cvt_pk_bf16(v0[0], v0[1]); w.y = cvt_pk_bf16(v0[2], v0[3]); w.z = cvt_pk_bf16(v1[0], v1[1]); w.w = cvt_pk_bf16(v1[2], v1[3]);
                    *(u32x4*)(dst + (size_t)R * ld + cl) = w;
                }
            }
    }
};
struct EpiGLU {
    Ctx C;
    __device__ __forceinline__ void operator()(const Acc& acc, const Unit& u, int wr, int wc, int fr, int fq) const {
        const int rbase = arow(u.pm), c0 = u.pn * 256;
#pragma unroll
        for (int ai = 0; ai < 2; ++ai)
#pragma unroll
            for (int m = 0; m < 4; ++m) {
                const int R = rbase + ai * 128 + wr * 64 + m * 16 + fr;
#pragma unroll
                for (int bj = 0; bj < 2; ++bj) {
                    const int cl = c0 + bj * 128 + wc * 32 + 8 * fq;
                    const u32x4 yv = *(const u32x4*)(YG + (size_t)R * 1024 + cl), zv = *(const u32x4*)(ZB0 + (size_t)R * 1024 + cl);
                    const f32x4 a0 = acc[ai][bj][m][0], a1 = acc[ai][bj][m][1];
                    float o[8];
                    o[0] = bflo(yv.x) * sigmoidf_(a0[0]) * siluf_(bflo(zv.x)); o[1] = bfhi(yv.x) * sigmoidf_(a0[1]) * siluf_(bfhi(zv.x));
                    o[2] = bflo(yv.y) * sigmoidf_(a0[2]) * siluf_(bflo(zv.y)); o[3] = bfhi(yv.y) * sigmoidf_(a0[3]) * siluf_(bfhi(zv.y));
                    o[4] = bflo(yv.z) * sigmoidf_(a1[0]) * siluf_(bflo(zv.z)); o[5] = bfhi(yv.z) * sigmoidf_(a1[1]) * siluf_(bfhi(zv.z));
                    o[6] = bflo(yv.w) * sigmoidf_(a1[2]) * siluf_(bflo(zv.w)); o[7] = bfhi(yv.w) * sigmoidf_(a1[3]) * siluf_(bfhi(zv.w));
                    u32x4 w; w.x = cvt_pk_bf16(o[0], o[1]); w.y = cvt_pk_bf16(o[2], o[3]); w.z = cvt_pk_bf16(o[4], o[5]); w.w = cvt_pk_bf16(o[6], o[7]);
                    *(u32x4*)(YCAT + (size_t)R * 3072 + 2048 + cl) = w;
                }
            }
    }
};
template <int LAYER> struct EpiOut {
    Ctx C;
    __device__ __forceinline__ void operator()(const Acc& acc, const Unit& u, int wr, int wc, int fr, int fq) const {
        const int rbase = arow(u.pm);
        const float* base = (LAYER == 0) ? C.x : C.out;
#pragma unroll
        for (int ai = 0; ai < 2; ++ai)
#pragma unroll
            for (int m = 0; m < 4; ++m) {
                const int rl = ai * 128 + wr * 64 + m * 16 + fr, R = rbase + rl, xr = u.pm * 256 + rl;
                float s = 0.f;
#pragma unroll
                for (int bj = 0; bj < 2; ++bj) {
                    const int cl = u.pn * 256 + bj * 128 + wc * 32 + 8 * fq;
                    const f32x4 h0 = *(const f32x4*)(base + (size_t)xr * DM + cl) + acc[ai][bj][m][0], h1 = *(const f32x4*)(base + (size_t)xr * DM + cl + 4) + acc[ai][bj][m][1];
                    *(f32x4*)(C.out + (size_t)xr * DM + cl) = h0; *(f32x4*)(C.out + (size_t)xr * DM + cl + 4) = h1;
                    s += (h0[0] * h0[0] + h0[1] * h0[1]) + (h0[2] * h0[2] + h0[3] * h0[3]) + (h1[0] * h1[0] + h1[1] * h1[1]) + (h1[2] * h1[2] + h1[3] * h1[3]);
                    if (LAYER == 0) {
                        const f32x4 w0 = *(const f32x4*)(C.norm_c_w + cl), w1 = *(const f32x4*)(C.norm_c_w + cl + 4);
                        u32x4 w; w.x = cvt_pk_bf16(h0[0] * w0[0], h0[1] * w0[1]); w.y = cvt_pk_bf16(h0[2] * w0[2], h0[3] * w0[3]); w.z = cvt_pk_bf16(h1[0] * w1[0], h1[1] * w1[1]); w.w = cvt_pk_bf16(h1[2] * w1[2], h1[3] * w1[3]);
                        *(u32x4*)(A1 + (size_t)R * DM + cl) = w;
                    }
                }
                s += __shfl_xor(s, 16); s += __shfl_xor(s, 32);
                if (fq == 0) unsafeAtomicAdd((LAYER == 0) ? (SSQ1 + R) : (SSQ2 + xr), s);
            }
    }
};
}

__device__ __forceinline__ f32x4 skinny16(const bf16_t* Ap, int lda, const bf16_t* Bp, int ldb, int K, int lane) {
    const bf16_t* a = Ap + (size_t)(lane & 15) * lda + (lane >> 4) * 8;
    const bf16_t* b = Bp + (size_t)(lane & 15) * ldb + (lane >> 4) * 8;
    f32x4 acc = {0.f, 0.f, 0.f, 0.f};
#pragma unroll 8
    for (int k = 0; k < K; k += 32) { const bf16x8 av = *(const bf16x8*)(a + k), bv = *(const bf16x8*)(b + k); acc = mfma16(av, bv, acc); }
    return acc;
}

__device__ __forceinline__ f32x4 skinny16_wg(const bf16_t* Ap, int lda, const bf16_t* Bp, int ldb, int K, LAS unsigned char* lds, int wave, int lane) {
    const int kw = K >> 3;
    const f32x4 part = skinny16(Ap + wave * kw, lda, Bp + wave * kw, ldb, kw, lane);
    LAS f32x4* red = (LAS f32x4*)lds;
    red[wave * 64 + lane] = part;
    __syncthreads();
    f32x4 r = red[lane];
#pragma unroll
    for (int w = 1; w < 8; ++w) r += red[w * 64 + lane];
    __syncthreads();
    return r;
}

__device__ __forceinline__ void transpose_item(const float* W, int K, int N, bf16_t* WT, LAS float* scr, int item, int lane) {
    const int nblk = (N + 31) / 32, kb = item / nblk, nb = item % nblk, k0 = 64 * kb, n0 = 32 * nb;
    const int nn = n0 + (lane & 31);
#pragma unroll 8
    for (int i = 0; i < 32; ++i) { const int kk = 2 * i + (lane >> 5); scr[kk * 33 + (lane & 31)] = (nn < N) ? W[(size_t)(k0 + kk) * N + nn] : 0.f; }
    LDS_FENCE();
    const int c = lane & 7;
#pragma unroll
    for (int j = 0; j < 4; ++j) { const int n = (lane >> 3) + 8 * j; const LAS float* s = scr + (8 * c) * 33 + n;
        u32x4 o; o.x = cvt_pk_bf16(s[0 * 33], s[1 * 33]); o.y = cvt_pk_bf16(s[2 * 33], s[3 * 33]); o.z = cvt_pk_bf16(s[4 * 33], s[5 * 33]); o.w = cvt_pk_bf16(s[6 * 33], s[7 * 33]);
        if (n0 + n < N) *(u32x4*)(WT + (size_t)(n0 + n) * K + k0 + 8 * c) = o; }
    LDS_FENCE();
}

__device__ __forceinline__ void transpose_item64(const float* W, int K, int N, bf16_t* WT, LAS float* scr, int item, int lane) {
    const int nblk = N / 64, kb = item / nblk, nb = item % nblk, k0 = 64 * kb, n0 = 64 * nb;
    const float* src = W + (size_t)(k0 + (lane >> 4)) * N + n0 + (lane & 15) * 4;
#pragma unroll
    for (int i = 0; i < 16; ++i) { const f32x4 v = *(const f32x4*)(src + (size_t)(4 * i) * N); LAS float* d = scr + (4 * i + (lane >> 4)) * 65 + (lane & 15) * 4; d[0] = v[0]; d[1] = v[1]; d[2] = v[2]; d[3] = v[3]; }
    LDS_FENCE();
    const int c = lane & 7;
#pragma unroll
    for (int j = 0; j < 8; ++j) { const int n = (lane >> 3) + 8 * j; const LAS float* t = scr + (8 * c) * 65 + n;
        u32x4 o; o.x = cvt_pk_bf16(t[0 * 65], t[1 * 65]); o.y = cvt_pk_bf16(t[2 * 65], t[3 * 65]); o.z = cvt_pk_bf16(t[4 * 65], t[5 * 65]); o.w = cvt_pk_bf16(t[6 * 65], t[7 * 65]);
        *(u32x4*)(WT + (size_t)(n0 + n) * K + k0 + 8 * c) = o; }
    LDS_FENCE();
}

__device__ __forceinline__ void p0_phase(const Ctx& C, LAS unsigned char* lds, int tid, int lane, int wave, int bid, int G) {
    LAS float* scr = (LAS float*)(lds + wave * 18432);
    const int gw = wave * G + bid, NGW = G * 8;
    constexpr int I1 = (2048 / 64) * (8192 / 64), IG = (1024 / 64) * (1024 / 64), IO1 = (3072 / 64) * (2048 / 64), IO2 = (2048 / 64) * (2048 / 64);
    for (int it = gw; it < I1 + IG + IO1 + IO2; it += NGW) {
        int r = it;
        if (r < I1) { transpose_item64(C.w_in_ab, 2048, 8192, W1T, scr, r, lane); continue; } r -= I1;
        if (r < IG) { transpose_item64(C.w_glu, 1024, 1024, WGLUT, scr, r, lane); continue; } r -= IG;
        if (r < IO1) { transpose_item64(C.w_out_ab, 3072, 2048, WO1T, scr, r, lane); continue; } r -= IO1;
        transpose_item64(C.w_out_c, 2048, 2048, WO2T, scr, r, lane);
    }
    for (int idx = gw; idx < 2 * 4112; idx += NGW) {
        const int b = idx / 4112, rr = idx % 4112;
        const float* src = (rr < 16) ? (C.meta + (size_t)rr * DM) : (C.x + ((size_t)b * SEQ + (rr - 16)) * DM);
        f32x4 v[8]; float s = 0.f;
#pragma unroll
        for (int j = 0; j < 8; ++j) { v[j] = *(const f32x4*)(src + (lane + 64 * j) * 4); s += (v[j][0] * v[j][0] + v[j][1] * v[j][1]) + (v[j][2] * v[j][2] + v[j][3] * v[j][3]); }
        const float rstd = rsqrtf(wave_sum(s) * (1.f / 2048.f) + EPS);
        bf16_t* dst = A0 + (size_t)(b * LP + PADR + rr) * DM;
#pragma unroll
        for (int j = 0; j < 8; ++j) { const f32x4 w = *(const f32x4*)(C.norm_ab_w + (lane + 64 * j) * 4);
            u32x2 o; o.x = cvt_pk_bf16(v[j][0] * rstd * w[0], v[j][1] * rstd * w[1]); o.y = cvt_pk_bf16(v[j][2] * rstd * w[2], v[j][3] * rstd * w[3]);
            *(u32x2*)(dst + (lane + 64 * j) * 4) = o; }
    }
    const int gt = bid * 512 + tid, NGT = G * 512;
    for (int idx = gt; idx < 4112 * 64; idx += NGT) {
        const int pos = idx >> 6, i = idx & 63;
        const double inv = exp(-(double)i * (9.210340371976184 / 64.0)); double s, c; dsincos((double)pos * inv, s, c);
        ROPE[idx] = (f32x2){(float)c, (float)s};
    }
    for (int idx = gt; idx < 4096; idx += NGT) {
        const int g = idx >> 6;
        const double lr = C.lam_re[idx], li = C.lam_im[idx], dt = exp((double)C.log_dt[g]);
        const double mag = exp(lr * dt); double s, c; dsincos(li * dt, s, c); const double ar = mag * c, ai = mag * s;
        S5AB[idx] = (f32x2){(float)ar, (float)ai};
        double pr = ar, pi = ai;
#pragma unroll
        for (int q = 0; q < 7; ++q) { const double nr_ = pr * pr - pi * pi, ni_ = 2.0 * pr * pi; pr = nr_; pi = ni_; }
        S5A128[idx] = (f32x2){(float)pr, (float)pi};
        const double den = lr * lr + li * li, nr = ar - 1.0, ni = ai, fre = (nr * lr + ni * li) / den, fim = (ni * lr - nr * li) / den;
        for (int h = 0; h < 16; ++h) { const double br = C.b_re[idx * 16 + h], bi = C.b_im[idx * 16 + h];
            S5BB[idx * 32 + h] = (float)(fre * br - fim * bi); S5BB[idx * 32 + 16 + h] = (float)(fre * bi + fim * br);
            const int p_ = idx & 63;
            S5BBT[(g * 128 + p_) * 32 + h] = f2bf((float)(fre * br - fim * bi)); S5BBT[(g * 128 + p_) * 32 + 16 + h] = 0;
            S5BBT[(g * 128 + 64 + p_) * 32 + h] = f2bf((float)(fre * bi + fim * br)); S5BBT[(g * 128 + 64 + p_) * 32 + 16 + h] = 0; }
    }
    for (int idx = gt; idx < 65536; idx += NGT) { const int gh = idx >> 6, p = idx & 63; S5C[gh * 128 + p] = f2bf(C.c_re[idx]); S5C[gh * 128 + 64 + p] = f2bf(-C.c_im[idx]); }
    for (int idx = gt; idx < NR; idx += NGT) SSQ1[idx] = 0.f;
    for (int idx = gt; idx < 8192; idx += NGT) SSQ2[idx] = 0.f;
    if (gt < 64) CTR[gt] = 0u;
}

template <int LAYER>
__device__ __forceinline__ void prep_item(const Ctx& C, int item, int tid, LAS unsigned char* lds) {
    LAS unsigned char* tl = lds + (unsigned)tid * 272u;
    const int b = item / (NCH * 6), n = (item / 6) % NCH, part = item % 6, r0 = n * 128;
    const int npad8 = (n == 0) ? 14 : 0;
    if (part < 2) {
        const int c = part * 512 + tid;
        const bf16_t* qraw = LAYER == 0 ? Q0RAW : Q1RAW; const bf16_t* kraw = LAYER == 0 ? K0RAW : K1RAW;
        bf16_t* qd = LAYER == 0 ? QD0 : QD1; bf16_t* kd = LAYER == 0 ? KD0 : KD1; bf16_t* kt = LAYER == 0 ? KT0 : KT1;
        if (LAYER == 0) {
            const int h = c >> 7, d = c & 127, pc = c ^ 64;
            const float lg = (float)log1p(-exp2(-5.0 - (double)h));
            bf16_t qo[8] = {0, 0, 0, 0, 0, 0, 0, 0}, ko[8] = {0, 0, 0, 0, 0, 0, 0, 0};
            int Rp = 0;
            for (int j8 = 0; j8 < 16; ++j8) {
                const int Rb = b * LP + r0 + j8 * 8;
                float q1[8], q2[8], k1[8], k2[8]; f32x2 cs[8];
                if (j8 >= npad8) {
#pragma unroll
                    for (int jj = 0; jj < 8; ++jj) {
                        const size_t o_ = (size_t)(Rb + jj) * 1024;
                        q1[jj] = bf2f(qraw[o_ + c]); q2[jj] = bf2f(qraw[o_ + pc]); k1[jj] = bf2f(kraw[o_ + c]); k2[jj] = bf2f(kraw[o_ + pc]);
                        cs[jj] = ROPE[(r0 + j8 * 8 + jj - PADR) * 64 + (d & 63)];
                    }
                }
                if (j8 > 0) {
#pragma unroll
                    for (int jj = 0; jj < 8; ++jj) { qd[(size_t)(Rp + jj) * 1024 + c] = qo[jj]; kd[(size_t)(Rp + jj) * 1024 + c] = ko[jj]; }
                }
                unsigned kp[4] = {0u, 0u, 0u, 0u};
                if (j8 >= npad8) {
                    float kv[8];
#pragma unroll
                    for (int jj = 0; jj < 8; ++jj) {
                        const float qr = (d < 64) ? (q1[jj] * cs[jj].x - q2[jj] * cs[jj].y) : (q2[jj] * cs[jj].y + q1[jj] * cs[jj].x);
                        const float kr = ((d < 64) ? (k1[jj] * cs[jj].x - k2[jj] * cs[jj].y) : (k2[jj] * cs[jj].y + k1[jj] * cs[jj].x)) * 0.08838834764831845f;
                        const float bj = lg * (float)(j8 * 8 + jj + 1);
                        qo[jj] = f2bf(qr * __expf(bj));
                        kv[jj] = kr * __expf(-bj);
                        ko[jj] = f2bf(kv[jj]);
                    }
                    kp[0] = cvt_pk_bf16(kv[0], kv[1]); kp[1] = cvt_pk_bf16(kv[2], kv[3]); kp[2] = cvt_pk_bf16(kv[4], kv[5]); kp[3] = cvt_pk_bf16(kv[6], kv[7]);
                } else {
#pragma unroll
                    for (int jj = 0; jj < 8; ++jj) { qo[jj] = 0; ko[jj] = 0; }
                }
                Rp = Rb;
                *(LAS u32x4*)(tl + j8 * 16) = (u32x4){kp[0], kp[1], kp[2], kp[3]};
            }
#pragma unroll
            for (int jj = 0; jj < 8; ++jj) { qd[(size_t)(Rp + jj) * 1024 + c] = qo[jj]; kd[(size_t)(Rp + jj) * 1024 + c] = ko[jj]; }
        } else {
            const int h = c >> 8, d = c & 255;
            float wg[16];
#pragma unroll
            for (int r = 0; r < 16; ++r) wg[r] = C.w_gate[r * 1024 + c];
            const float bg = C.b_gate[c];
            bf16_t* ktp = kt + ((size_t)((b * 4 + h) * NCH + n) * 256 + d) * 128;
            float bc = 0.f;
            for (int j8 = 0; j8 < 16; ++j8) {
                unsigned kp[4] = {0u, 0u, 0u, 0u};
                if (j8 >= npad8) {
                    float kv[8];
#pragma unroll
                    for (int jj = 0; jj < 8; ++jj) {
                        const int R = b * LP + r0 + j8 * 8 + jj;
                        const f32x4 g0 = *(const f32x4*)(GLOW + (size_t)R * 16), g1 = *(const f32x4*)(GLOW + (size_t)R * 16 + 4), g2 = *(const f32x4*)(GLOW + (size_t)R * 16 + 8), g3 = *(const f32x4*)(GLOW + (size_t)R * 16 + 12);
                        float xg = bg;
                        xg += g0[0] * wg[0] + g0[1] * wg[1] + g0[2] * wg[2] + g0[3] * wg[3]; xg += g1[0] * wg[4] + g1[1] * wg[5] + g1[2] * wg[6] + g1[3] * wg[7];
                        xg += g2[0] * wg[8] + g2[1] * wg[9] + g2[2] * wg[10] + g2[3] * wg[11]; xg += g3[0] * wg[12] + g3[1] * wg[13] + g3[2] * wg[14] + g3[3] * wg[15];
                        const float la = (fminf(xg, 0.f) - __logf(1.f + __expf(-fabsf(xg)))) * 0.0625f;
                        bc += la;
                        const float q = bf2f(qraw[(size_t)R * 1024 + c]), k = bf2f(kraw[(size_t)R * 1024 + c]);
                        qd[(size_t)R * 1024 + c] = f2bf(q * 0.0625f * __expf(bc));
                        kv[jj] = k * __expf(-bc);
                        kd[(size_t)R * 1024 + c] = f2bf(kv[jj]);
                    }
                    kp[0] = cvt_pk_bf16(kv[0], kv[1]); kp[1] = cvt_pk_bf16(kv[2], kv[3]); kp[2] = cvt_pk_bf16(kv[4], kv[5]); kp[3] = cvt_pk_bf16(kv[6], kv[7]);
                } else {
#pragma unroll
                    for (int jj = 0; jj < 8; ++jj) { const int R = b * LP + r0 + j8 * 8 + jj; qd[(size_t)R * 1024 + c] = 0; kd[(size_t)R * 1024 + c] = 0; }
                }
                *(LAS u32x4*)(tl + j8 * 16) = (u32x4){kp[0], kp[1], kp[2], kp[3]};
            }
            DEC1[((b * 4 + h) * NCH + n) * 256 + d] = __expf(bc);
        }
    } else {
        const int v = (part - 2) * 512 + tid;
        constexpr int DVp = LAYER == 0 ? 256 : 512;
        const bf16_t* vraw = LAYER == 0 ? V0RAW : V1RAW; bf16_t* vt = (LAYER == 0 ? VT0 : VT1) + ((size_t)(((b * 2048 + v) / DVp) * NCH + n) * DVp + (v % DVp)) * 128;
        for (int j8 = 0; j8 < 16; ++j8) {
            unsigned short e[8] = {0, 0, 0, 0, 0, 0, 0, 0};
            if (j8 >= npad8) {
                const bf16_t* vp = vraw + (size_t)(b * LP + r0 + j8 * 8) * 2048 + v;
#pragma unroll
                for (int jj = 0; jj < 8; ++jj) e[jj] = vp[jj * 2048];
            }
            u32x4 w; w.x = e[0] | ((unsigned)e[1] << 16); w.y = e[2] | ((unsigned)e[3] << 16); w.z = e[4] | ((unsigned)e[5] << 16); w.w = e[6] | ((unsigned)e[7] << 16);
            *(LAS u32x4*)(tl + j8 * 16) = w;
        }
    }
    __syncthreads();
#pragma unroll 4
    for (int i = 0; i < 16; ++i) {
        const int p_ = tid + i * 512, rr = p_ >> 4, c8 = p_ & 15;
        bf16_t* dst;
        if (part < 2) {
            const int c = part * 512 + rr;
            if (LAYER == 0) dst = KT0 + ((size_t)((b * 8 + (c >> 7)) * NCH + n) * 128 + (c & 127)) * 128;
            else dst = KT1 + ((size_t)((b * 4 + (c >> 8)) * NCH + n) * 256 + (c & 255)) * 128;
        } else {
            constexpr int DVq = LAYER == 0 ? 256 : 512;
            const int rowid = b * 2048 + (part - 2) * 512 + rr;
            dst = (LAYER == 0 ? VT0 : VT1) + ((size_t)((rowid / DVq) * NCH + n) * DVq + (rowid % DVq)) * 128;
        }
        *(u32x4*)(dst + c8 * 8) = *(const LAS u32x4*)(lds + (unsigned)rr * 272u + c8 * 16);
    }
    __syncthreads();
}

template <bool FULL>
__device__ __forceinline__ void s5_task(const Ctx& C, int task, int lane, LAS bf16_t* xs) {
    const int b = task / (64 * NCH), g = (task / NCH) % 64, n = task % NCH, p = lane, gp = g * 64 + p;
    const int fr = lane & 15, fq = lane >> 4;
    LAS float* xf = (LAS float*)(xs + 16 * 136);
    bf16x8 bbf[8];
#pragma unroll
    for (int blk = 0; blk < 8; ++blk) bbf[blk] = *(const bf16x8*)(S5BBT + (size_t)(g * 128 + blk * 16 + fr) * 32 + fq * 8);
    const f32x2 a = S5AB[gp];
    float xr = 0.f, xi = 0.f;
    bf16x8 cf[4];
    float dv = 0.f;
    if (FULL) {
        const f32x2 a128 = S5A128[gp];
        const float* e = S5E + (size_t)((b * 64 + g) * NCH) * 128;
        for (int m0 = 0; m0 < n; m0 += 8) {
            float er[8], ei[8];
#pragma unroll
            for (int k = 0; k < 8; ++k) { const int mm = (m0 + k < n) ? m0 + k : n - 1; er[k] = e[mm * 128 + p]; ei[k] = e[mm * 128 + 64 + p]; }
#pragma unroll
            for (int k = 0; k < 8; ++k) { const float nr = a128.x * xr - a128.y * xi + er[k], ni = a128.x * xi + a128.y * xr + ei[k]; const bool ok = (m0 + k < n); xr = ok ? nr : xr; xi = ok ? ni : xi; }
        }
#pragma unroll
        for (int kk = 0; kk < 4; ++kk) cf[kk] = *(const bf16x8*)(S5C + (g * 16 + fr) * 128 + kk * 32 + fq * 8);
        dv = C.s5d[g * 16 + fr];
    }
    const int j16s = (n == 0) ? 7 : 0;
    bf16x8 uf = {0, 0, 0, 0, 0, 0, 0, 0}, ufn = {0, 0, 0, 0, 0, 0, 0, 0};
    if (fq < 2) uf = *(const bf16x8*)(U0 + (size_t)(b * LP + n * 128 + j16s * 16 + fr) * 1024 + g * 16 + fq * 8);
    bf16_t ue[4] = {0, 0, 0, 0}, uen[4] = {0, 0, 0, 0};
    if (FULL) {
#pragma unroll
        for (int j = 0; j < 4; ++j) ue[j] = U0[(size_t)(b * LP + n * 128 + j16s * 16 + 4 * fq + j) * 1024 + g * 16 + fr];
    }
    for (int j16 = j16s; j16 < 8; ++j16) {
        const int Rb = b * LP + n * 128 + j16 * 16;
        if (fq < 2 && j16 < 7) ufn = *(const bf16x8*)(U0 + (size_t)(Rb + 16 + fr) * 1024 + g * 16 + fq * 8);
        if (FULL && j16 < 7) {
#pragma unroll
            for (int j = 0; j < 4; ++j) uen[j] = U0[(size_t)(Rb + 16 + 4 * fq + j) * 1024 + g * 16 + fr];
        }
#pragma unroll
        for (int blk = 0; blk < 8; ++blk) { const f32x4 d = mfma16(uf, bbf[blk], (f32x4){0.f, 0.f, 0.f, 0.f});
#pragma unroll
            for (int j = 0; j < 4; ++j) xf[(4 * fq + j) * 132 + blk * 16 + fr] = d[j]; }
        LDS_FENCE();
#pragma unroll
        for (int jj = 0; jj < 16; ++jj) {
            const float bur = xf[jj * 132 + p], bui = xf[jj * 132 + 64 + p];
            const float nr = a.x * xr - a.y * xi + bur, ni = a.x * xi + a.y * xr + bui; xr = nr; xi = ni;
            if (FULL) { xs[jj * 136 + p] = f2bf(xr); xs[jj * 136 + 64 + p] = f2bf(xi); }
        }
        LDS_FENCE();
        if (FULL) {
            f32x4 acc = {0.f, 0.f, 0.f, 0.f};
            bf16x8 af[4];
#pragma unroll
            for (int kk = 0; kk < 4; ++kk) af[kk] = *(const LAS bf16x8*)(xs + fr * 136 + kk * 32 + fq * 8);
            LDS_FENCE();
#pragma unroll
            for (int kk = 0; kk < 4; ++kk) acc = mfma16(af[kk], cf[kk], acc);
#pragma unroll
            for (int j = 0; j < 4; ++j) { const size_t o = (size_t)(Rb + 4 * fq + j) * 1024 + g * 16 + fr; const float y = acc[j] + dv * bf2f(ue[j]); YG[o] = f2bf(gelu_tanh(y)); }
        }
        uf = ufn;
#pragma unroll
        for (int j = 0; j < 4; ++j) ue[j] = uen[j];
    }
    if (!FULL) { float* e = S5E + (size_t)((b * 64 + g) * NCH + n) * 128; e[p] = xr; e[64 + p] = xi; }
}

template <int LAYER>
__device__ __forceinline__ void kvscan_task(const Ctx& C, int task, int lane) {
    constexpr int H = LAYER == 0 ? 8 : 4, DK = LAYER == 0 ? 128 : 256, DV = LAYER == 0 ? 256 : 512, NDB = DK / 64, NVB = DV / 16;
    const int db = task % NDB, vb = (task / NDB) % NVB, bh = task / (NDB * NVB), h = bh % H;
    const int fr = lane & 15, fq = lane >> 4, d0 = db * 64, v0 = vb * 16;
    const bf16_t* kt = (LAYER == 0 ? KT0 : KT1) + (size_t)(bh * DK + d0 + fr) * LP + fq * 8;
    const bf16_t* vt = (LAYER == 0 ? VT0 : VT1) + (size_t)(bh * DV + v0 + fr) * LP + fq * 8;
    bf16_t* sp = (LAYER == 0 ? SP0 : SP1) + (size_t)(bh * NCH) * DV * DK + (size_t)(v0 + fr) * DK + d0 + 4 * fq;
    const float g128 = (LAYER == 0) ? (float)exp(128.0 * log1p(-exp2(-5.0 - (double)h))) : 1.f;
    f32x4 acc[4];
#pragma unroll
    for (int i = 0; i < 4; ++i) acc[i] = (f32x4){0.f, 0.f, 0.f, 0.f};
    bf16x8 fa[4][4], fb[4];
#pragma unroll
    for (int kk = 0; kk < 4; ++kk) { fb[kk] = *(const bf16x8*)(vt + kk * 32);
#pragma unroll
        for (int blk = 0; blk < 4; ++blk) fa[blk][kk] = *(const bf16x8*)(kt + (size_t)(blk * 16) * LP + kk * 32); }
    for (int n = 0; n < NCH; ++n) {
#pragma unroll
        for (int blk = 0; blk < 4; ++blk) { u32x2 w; w.x = cvt_pk_bf16(acc[blk][0], acc[blk][1]); w.y = cvt_pk_bf16(acc[blk][2], acc[blk][3]); *(u32x2*)(sp + (size_t)n * DV * DK + blk * 16) = w; }
        if (n == NCH - 1) break;
        bf16x8 na[4][4], nb[4];
        const int nn = (n + 1 < NCH - 1) ? n + 1 : n;
#pragma unroll
        for (int kk = 0; kk < 4; ++kk) { nb[kk] = *(const bf16x8*)(vt + nn * 128 + kk * 32);
#pragma unroll
            for (int blk = 0; blk < 4; ++blk) na[blk][kk] = *(const bf16x8*)(kt + (size_t)(blk * 16) * LP + nn * 128 + kk * 32); }
#pragma unroll
        for (int kk = 0; kk < 4; ++kk)
#pragma unroll
            for (int blk = 0; blk < 4; ++blk) acc[blk] = mfma16(fa[blk][kk], fb[kk], acc[blk]);
        if (LAYER == 0) {
#pragma unroll
            for (int blk = 0; blk < 4; ++blk) acc[blk] = acc[blk] * g128;
        } else {
#pragma unroll
            for (int blk = 0; blk < 4; ++blk) { const f32x4 dc = *(const f32x4*)(DEC1 + (size_t)(bh * NCH + n) * DK + d0 + blk * 16 + 4 * fq); acc[blk] = acc[blk] * dc; }
        }
#pragma unroll
        for (int kk = 0; kk < 4; ++kk) { fb[kk] = nb[kk];
#pragma unroll
            for (int blk = 0; blk < 4; ++blk) fa[blk][kk] = na[blk][kk]; }
    }
}

template <int LAYER>
__device__ __forceinline__ void mixout_task(const Ctx& C, int task, int lane, LAS bf16_t* xs) {
    constexpr int H = LAYER == 0 ? 8 : 4, DK = LAYER == 0 ? 128 : 256, DV = LAYER == 0 ? 256 : 512, NKK = DK / 32, NVB = DV / 16;
    constexpr int TPB = LAYER == 0 ? 257 : 256;
    const int bh = task / TPB, rem = task % TPB, b = bh / H, h = bh % H;
    const int n = (rem == 256) ? 0 : 1 + (rem >> 3), rb = (rem == 256) ? 7 : (rem & 7);
    const int fr = lane & 15, fq = lane >> 4;
    const bf16_t* qd = LAYER == 0 ? QD0 : QD1; const bf16_t* kd = LAYER == 0 ? KD0 : KD1;
    const int Rc = b * LP + n * 128, R0 = Rc + rb * 16;
    bf16x8 qf[NKK];
#pragma unroll
    for (int kk = 0; kk < NKK; ++kk) qf[kk] = *(const bf16x8*)(qd + (size_t)(R0 + fr) * 1024 + h * DK + kk * 32 + fq * 8);
    for (int jb = 0; jb <= rb; ++jb) {
        f32x4 s = {0.f, 0.f, 0.f, 0.f};
        const bf16_t* kp = kd + (size_t)(Rc + jb * 16 + fr) * 1024 + h * DK + fq * 8;
#pragma unroll
        for (int kk = 0; kk < NKK; ++kk) s = mfma16(qf[kk], *(const bf16x8*)(kp + kk * 32), s);
#pragma unroll
        for (int j = 0; j < 4; ++j) { float v = s[j]; if (jb == rb && fr > 4 * fq + j) v = 0.f; xs[(4 * fq + j) * 136 + jb * 16 + fr] = f2bf(v); }
    }
    if ((rb & 1) == 0) {
#pragma unroll
        for (int j = 0; j < 4; ++j) xs[(4 * fq + j) * 136 + (rb + 1) * 16 + fr] = 0;
    }
    const int nks = (rb >> 1) + 1;
    bf16x8 sf[4];
    LDS_FENCE();
#pragma unroll
    for (int kk = 0; kk < 4; ++kk) sf[kk] = *(const LAS bf16x8*)(xs + fr * 136 + (kk < nks ? kk : 0) * 32 + fq * 8);
    LDS_FENCE();
    const bf16_t* vt = (LAYER == 0 ? VT0 : VT1) + (size_t)(bh * DV + fr) * LP + n * 128 + fq * 8;
    const bf16_t* sp = (LAYER == 0 ? SP0 : SP1) + (size_t)(bh * NCH + n) * DV * DK + (size_t)fr * DK + fq * 8;
    f32x4 acc[NVB];
    float ssq[4] = {0.f, 0.f, 0.f, 0.f};
#pragma unroll
    for (int vb = 0; vb < NVB; ++vb) {
        f32x4 o = {0.f, 0.f, 0.f, 0.f};
#pragma unroll
        for (int kk = 0; kk < 4; ++kk) if (kk < nks) o = mfma16(sf[kk], *(const bf16x8*)(vt + (size_t)(vb * 16) * LP + kk * 32), o);
#pragma unroll
        for (int kk = 0; kk < NKK; ++kk) if (DBG_INTER) o = mfma16(qf[kk], *(const bf16x8*)(sp + (size_t)(vb * 16) * DK + kk * 32), o);
        acc[vb] = o;
#pragma unroll
        for (int j = 0; j < 4; ++j) ssq[j] += o[j] * o[j];
    }
    float rstd[4];
#pragma unroll
    for (int j = 0; j < 4; ++j) { float s = ssq[j]; s += __shfl_xor(s, 1); s += __shfl_xor(s, 2); s += __shfl_xor(s, 4); s += __shfl_xor(s, 8); rstd[j] = rsqrtf(s * (1.f / DV) + EPS); }
    const float* nw = (LAYER == 0 ? C.ret_norm_w : C.gla_norm_w) + h * DV + fr;
    const bf16_t* zp = (LAYER == 0 ? ZA0 : Z1) + h * DV + fr;
    bf16_t* yp = (LAYER == 0 ? YCAT : Y1) + h * DV + fr;
    constexpr int YLD = LAYER == 0 ? 3072 : 2048;
#pragma unroll
    for (int vb = 0; vb < NVB; ++vb) {
        const float w = nw[vb * 16];
#pragma unroll
        for (int j = 0; j < 4; ++j) { const int R = R0 + 4 * fq + j; const float z = bf2f(zp[(size_t)R * 2048 + vb * 16]); yp[(size_t)R * YLD + vb * 16] = DBG_NORM ? f2bf(acc[vb][j] * rstd[j] * w * siluf_(z)) : f2bf(acc[vb][j]); }
    }
}


__device__ __forceinline__ int block_fetch(unsigned* ctr, LAS int* slot, int tid) { __syncthreads(); if (tid == 0) *slot = (int)atomicAdd(ctr, 1u); __syncthreads(); return (int)__builtin_amdgcn_readfirstlane((unsigned)*slot); }
template <int LAYER>
__device__ __forceinline__ void kvscan_wg(const Ctx& C, int task, LAS unsigned char* lds, int tid, int lane, int wave) {
    constexpr int H = LAYER == 0 ? 8 : 4, DK = LAYER == 0 ? 128 : 256, DV = LAYER == 0 ? 256 : 512, NVG = DV / 32, NB = DK / 64, TP = 136, TILEB = DK * TP * 2, NPC = DK / 32;
    constexpr int VTO = 2 * TILEB + 2048, VTB = 32 * TP * 2;
    const int bh = task / NVG, vg = task % NVG, h = bh % H, vb = wave & 1, dh = wave >> 1, fr = lane & 15, fq = lane >> 4;
    const bf16_t* ktg = (LAYER == 0 ? KT0 : KT1) + (size_t)(bh * NCH) * DK * 128;
    const bf16_t* vtg = (LAYER == 0 ? VT0 : VT1) + (size_t)(bh * NCH) * DV * 128 + (size_t)(vg * 32) * 128;
    bf16_t* sp = (LAYER == 0 ? SP0 : SP1) + (size_t)(bh * NCH) * DV * DK + (size_t)(vg * 32 + vb * 16 + fr) * DK + dh * (DK / 4) + 4 * fq;
    const float g128 = (LAYER == 0) ? (float)exp(128.0 * log1p(-exp2(-5.0 - (double)h))) : 1.f;
    LAS float* decl = (LAS float*)(lds + 2 * TILEB);
    f32x4 acc[NB];
#pragma unroll
    for (int i = 0; i < NB; ++i) acc[i] = (f32x4){0.f, 0.f, 0.f, 0.f};
    u32x4 r0[NPC], r1[NPC], v0, v1; f32x4 d0 = {1.f, 1.f, 1.f, 1.f}, d1 = {1.f, 1.f, 1.f, 1.f};
    const unsigned kvo = (unsigned)((tid >> 4) * 128 + (tid & 15) * 8) * 2u;
    const unsigned lwo = (unsigned)((tid >> 4) * TP + (tid & 15) * 8) * 2u;
    constexpr int RB = DK / 2, VPT = 256 / RB, PPR = RB / 16, NST = 16 * PPR / 64;
    const unsigned spw = (unsigned)(((4 * wave + ((fr / VPT) & 3) + 32 * ((fr / VPT) >> 2)) * TP) * 2 + (fr % VPT) * RB + fq * 8);
    unsigned spr[NST]; bf16_t* spg[NST];
#pragma unroll
    for (int s_ = 0; s_ < NST; ++s_) { const int P_ = lane + 64 * s_, v_ = P_ / PPR, c_ = P_ % PPR, k_ = v_ / VPT;
        spr[s_] = (unsigned)(((4 * wave + (k_ & 3) + 32 * (k_ >> 2)) * TP) * 2 + (v_ % VPT) * RB + c_ * 16);
        spg[s_] = (LAYER == 0 ? SP0 : SP1) + (size_t)(bh * NCH) * DV * DK + (size_t)(vg * 32 + vb * 16 + v_) * DK + dh * (DK / 4) + c_ * 8; }
#define KV_SPSTORE(n_, fb_) do { \
        _Pragma("unroll") for (int blk = 0; blk < NB; ++blk) { u32x2 w; w.x = cvt_pk_bf16(acc[blk][0], acc[blk][1]); w.y = cvt_pk_bf16(acc[blk][2], acc[blk][3]); *(LAS u32x2*)(lds + (fb_) * TILEB + spw + blk * 32) = w; } \
        LDS_FENCE(); \
        { u32x4 t_[NST]; _Pragma("unroll") for (int s_ = 0; s_ < NST; ++s_) t_[s_] = *(const LAS u32x4*)(lds + (fb_) * TILEB + spr[s_]); \
          LDS_FENCE(); \
          _Pragma("unroll") for (int s_ = 0; s_ < NST; ++s_) *(u32x4*)(spg[s_] + (size_t)(n_) * DV * DK) = t_[s_]; } } while (0)
#define KV_LOAD(R, D, V, nn) do { _Pragma("unroll") for (int i = 0; i < NPC; ++i) { R[i] = *(const u32x4*)((const char*)(ktg + (size_t)(nn) * DK * 128 + (i * 32) * 128) + kvo); } \
        V = *(const u32x4*)((const char*)(vtg + (size_t)(nn) * DV * 128) + kvo); \
        if (LAYER == 1 && tid < DK / 4) D = *(const f32x4*)(DEC1 + (size_t)(bh * NCH + (nn)) * DK + tid * 4); } while (0)
#define KV_WRITE(R, D, V, bb) do { _Pragma("unroll") for (int i = 0; i < NPC; ++i) { *(LAS u32x4*)(lds + (bb) * TILEB + i * 32 * TP * 2 + lwo) = R[i]; } \
        *(LAS u32x4*)(lds + VTO + (bb) * VTB + lwo) = V; \
        if (LAYER == 1 && tid < DK / 4) *(LAS f32x4*)(decl + (bb) * DK + tid * 4) = D; } while (0)
#define KV_STEP(n_, RW, DW, VW) do { \
        KV_SPSTORE(n_, ((n_) + 1) & 1); \
        KV_WRITE(RW, DW, VW, ((n_) + 1) & 1); \
        KV_LOAD(RW, DW, VW, ((n_) + 3 < 32 ? (n_) + 3 : 31)); \
        { const LAS unsigned char* tb = lds + ((n_) & 1) * TILEB + ((dh * (DK / 4) + fr) * TP + fq * 8) * 2; \
          const LAS unsigned char* vbp = lds + VTO + ((n_) & 1) * VTB + ((vb * 16 + fr) * TP + fq * 8) * 2; \
          _Pragma("unroll") for (int kk = 0; kk < 4; ++kk) { bf16x8 af[NB]; const bf16x8 bfv = *(const LAS bf16x8*)(vbp + kk * 64); \
            _Pragma("unroll") for (int blk = 0; blk < NB; ++blk) af[blk] = *(const LAS bf16x8*)(tb + (blk * 16 * TP + kk * 32) * 2); \
            _Pragma("unroll") for (int blk = 0; blk < NB; ++blk) acc[blk] = mfma16(af[blk], bfv, acc[blk]); } } \
        if (LAYER == 0) { _Pragma("unroll") for (int blk = 0; blk < NB; ++blk) acc[blk] = acc[blk] * g128; } \
        else { _Pragma("unroll") for (int blk = 0; blk < NB; ++blk) { const f32x4 dc = *(const LAS f32x4*)(decl + ((n_) & 1) * DK + dh * (DK / 4) + blk * 16 + 4 * fq); acc[blk] = acc[blk] * dc; } } \
        LBAR(); } while (0)
    KV_LOAD(r0, d0, v0, 0); KV_WRITE(r0, d0, v0, 0); KV_LOAD(r1, d1, v1, 1); KV_LOAD(r0, d0, v0, 2);
    LBAR();
    for (int nb = 0; nb < 32; nb += 2) {
        KV_STEP(nb + 0, r1, d1, v1);
        KV_STEP(nb + 1, r0, d0, v0);
    }
    KV_SPSTORE(32, 1);
#undef KV_LOAD
#undef KV_WRITE
#undef KV_STEP
#undef KV_SPSTORE
    LBAR();
}

template <int LAYER>
__device__ __forceinline__ void mixout_wg(const Ctx& C, int task, LAS unsigned char* lds, int tid, int lane, int wave) {
    constexpr int H = LAYER == 0 ? 8 : 4, DK = LAYER == 0 ? 128 : 256, DV = LAYER == 0 ? 256 : 512, NKK = DK / 32, NSLAB = DV / 64, KP = DK + 8;
    constexpr int NSP = DK / 64, XSB = 8 * 4352, SPB = 64 * KP * 2, SLABB = SPB + 64 * 136 * 2, YLD = LAYER == 0 ? 3072 : 2048;
    const int bh = (LAYER == 0) ? task / NCH : task / 32, n = (LAYER == 0) ? task % NCH : 1 + task % 32, b = bh / H, h = bh % H, rb = wave;
    const int fr = lane & 15, fq = lane >> 4;
    const bf16_t* qd = LAYER == 0 ? QD0 : QD1; const bf16_t* kd = LAYER == 0 ? KD0 : KD1;
    const int Rc = b * LP + n * 128, R0 = Rc + rb * 16;
    LAS bf16_t* xs = (LAS bf16_t*)(lds + wave * 4352);
    const bf16_t* spg = (LAYER == 0 ? SP0 : SP1) + (size_t)(bh * NCH + n) * DV * DK;
    const bf16_t* vtg = (LAYER == 0 ? VT0 : VT1) + (size_t)(bh * NCH + n) * DV * 128;
    u32x4 rs[NSP], rv[2];
    const unsigned spo = (unsigned)((tid / (DK / 8)) * DK + (tid % (DK / 8)) * 8) * 2u, vto = (unsigned)((tid >> 4) * 128 + (tid & 15) * 8) * 2u;
#define MX_LOAD(s_) do { _Pragma("unroll") for (int i = 0; i < NSP; ++i) { rs[i] = *(const u32x4*)((const char*)(spg + (size_t)((s_) * 64 + i * (4096 / DK)) * DK) + spo); } \
        _Pragma("unroll") for (int i = 0; i < 2; ++i) { rv[i] = *(const u32x4*)((const char*)(vtg + (size_t)((s_) * 64 + i * 32) * 128) + vto); } } while (0)
#define MX_WRITE(bb) do { _Pragma("unroll") for (int i = 0; i < NSP; ++i) { const int p_ = tid + i * 512, row_ = p_ / (DK / 8), c8_ = p_ % (DK / 8); *(LAS u32x4*)(lds + XSB + (bb) * SLABB + (row_ * KP + c8_ * 8) * 2) = rs[i]; } \
        _Pragma("unroll") for (int i = 0; i < 2; ++i) { const int p_ = tid + i * 512, row_ = p_ >> 4, c8_ = p_ & 15; *(LAS u32x4*)(lds + XSB + (bb) * SLABB + SPB + (row_ * 136 + c8_ * 8) * 2) = rv[i]; } } while (0)
    bf16x8 qf[NKK];
#pragma unroll
    for (int kk = 0; kk < NKK; ++kk) qf[kk] = *(const bf16x8*)(qd + (size_t)(R0 + fr) * 1024 + h * DK + kk * 32 + fq * 8);
    {
        constexpr int NKP = DK / 32;
        u32x4 rk[NKP];
        const unsigned ko = (unsigned)((tid / (DK / 8)) * 1024 + (tid % (DK / 8)) * 8) * 2u;
#pragma unroll
        for (int i = 0; i < NKP; ++i) rk[i] = *(const u32x4*)((const char*)(kd + (size_t)(Rc + i * (4096 / DK)) * 1024 + h * DK) + ko);
#pragma unroll
        for (int i = 0; i < NKP; ++i) { const int p_ = tid + i * 512, row_ = p_ / (DK / 8), c8_ = p_ % (DK / 8); *(LAS u32x4*)(lds + XSB + (row_ * KP + c8_ * 8) * 2) = rk[i]; }
        LBAR();
    }
    MX_LOAD(0);
    for (int jb = 0; jb <= rb; ++jb) {
        f32x4 s = {0.f, 0.f, 0.f, 0.f};
        const LAS unsigned char* kp = lds + XSB + ((jb * 16 + fr) * KP + fq * 8) * 2;
#pragma unroll
        for (int kk = 0; kk < NKK; ++kk) s = mfma16(qf[kk], *(const LAS bf16x8*)(kp + kk * 64), s);
#pragma unroll
        for (int j = 0; j < 4; ++j) { float v = s[j]; if (jb == rb && fr > 4 * fq + j) v = 0.f; xs[(4 * fq + j) * 136 + jb * 16 + fr] = f2bf(v); }
    }
    if ((rb & 1) == 0) {
#pragma unroll
        for (int j = 0; j < 4; ++j) xs[(4 * fq + j) * 136 + (rb + 1) * 16 + fr] = 0;
    }
    const int nks = (rb >> 1) + 1;
    LBAR();
    MX_WRITE(0); MX_LOAD(1);
    LBAR();
    f32x4 acc[NSLAB * 4];
    float ssq[4] = {0.f, 0.f, 0.f, 0.f};
#pragma unroll
    for (int s_ = 0; s_ < NSLAB; ++s_) {
        const LAS unsigned char* sb = lds + XSB + (s_ & 1) * SLABB;
#pragma unroll
        for (int vb = 0; vb < 4; ++vb) {
            f32x4 o = {0.f, 0.f, 0.f, 0.f};
#pragma unroll
            for (int kk = 0; kk < 4; ++kk) if (kk < nks) o = mfma16(*(const LAS bf16x8*)(xs + fr * 136 + kk * 32 + fq * 8), *(const LAS bf16x8*)(sb + SPB + ((vb * 16 + fr) * 136 + kk * 32 + fq * 8) * 2), o);
#pragma unroll
            for (int k4 = 0; k4 < NKK; k4 += 4) { bf16x8 pf[4];
#pragma unroll
                for (int kk = 0; kk < 4; ++kk) pf[kk] = *(const LAS bf16x8*)(sb + ((vb * 16 + fr) * KP + (k4 + kk) * 32 + fq * 8) * 2);
#pragma unroll
                for (int kk = 0; kk < 4; ++kk) o = mfma16(qf[k4 + kk], pf[kk], o); }
            acc[s_ * 4 + vb] = o;
#pragma unroll
            for (int j = 0; j < 4; ++j) ssq[j] += o[j] * o[j];
        }
        if (s_ + 1 < NSLAB) { MX_WRITE((s_ + 1) & 1); if (s_ + 2 < NSLAB) MX_LOAD(s_ + 2); }
        LBAR();
    }
#undef MX_LOAD
#undef MX_WRITE
    float rstd[4];
#pragma unroll
    for (int j = 0; j < 4; ++j) { float s = ssq[j]; s += __shfl_xor(s, 1); s += __shfl_xor(s, 2); s += __shfl_xor(s, 4); s += __shfl_xor(s, 8); rstd[j] = rsqrtf(s * (1.f / DV) + EPS); }
    constexpr int ZP = DV + 8, NRW = DV / 512 > 0 ? DV / 512 : 1;
    LAS bf16_t* zt = (LAS bf16_t*)(lds + wave * 17408);
    const bf16_t* zg = (LAYER == 0 ? ZA0 : Z1) + (size_t)R0 * 2048 + h * DV;
    if (DV == 512) {
#pragma unroll
        for (int i = 0; i < 16; ++i) *(LAS u32x4*)(zt + i * ZP + lane * 8) = *(const u32x4*)(zg + (size_t)i * 2048 + lane * 8);
    } else {
#pragma unroll
        for (int i = 0; i < 8; ++i) { const int row = 2 * i + (lane >> 5), c8 = lane & 31; *(LAS u32x4*)(zt + row * ZP + c8 * 8) = *(const u32x4*)(zg + (size_t)row * 2048 + c8 * 8); }
    }
    LDS_FENCE();
    const float* nw = (LAYER == 0 ? C.ret_norm_w : C.gla_norm_w) + h * DV + fr;
#pragma unroll
    for (int vb = 0; vb < NSLAB * 4; ++vb) {
        const float w = nw[vb * 16];
#pragma unroll
        for (int j = 0; j < 4; ++j) { LAS bf16_t* e = zt + (4 * fq + j) * ZP + vb * 16 + fr; const float z = bf2f(*e); *e = f2bf(acc[vb][j] * rstd[j] * w * siluf_(z)); }
    }
    LDS_FENCE();
    bf16_t* yg = (LAYER == 0 ? YCAT : Y1) + (size_t)R0 * YLD + h * DV;
    if (DV == 512) {
#pragma unroll
        for (int i = 0; i < 16; ++i) *(u32x4*)(yg + (size_t)i * YLD + lane * 8) = *(const LAS u32x4*)(zt + i * ZP + lane * 8);
    } else {
#pragma unroll
        for (int i = 0; i < 8; ++i) { const int row = 2 * i + (lane >> 5), c8 = lane & 31; *(u32x4*)(yg + (size_t)row * YLD + c8 * 8) = *(const LAS u32x4*)(zt + row * ZP + c8 * 8); }
    }
    LBAR();
}

__device__ __forceinline__ void phase1(const Ctx& C, LAS unsigned char* lds, int tid, int lane, int wave, int bid, int G, int rep) {
    const int gw = wave * G + bid, NGW = G * 8; LAS bf16_t* xs = (LAS bf16_t*)(lds + wave * 16384); LAS int* slot = (LAS int*)(lds + 163776); (void)gw; (void)NGW; (void)xs; (void)slot;
        pg8::Gemm g{A0, W1T, 2048, 2048, 2048}; pg8::StaticOrder S; S.init(8192, 8192, G, bid);
        pg8::EpiProj<0> E{C};
        pg8::gemm_phase(lds, g, S, E);
        for (int t = bid; t < 512; t += G) {
            const f32x4 acc = skinny16_wg(A0 + (size_t)PADR * 2048, 2048, W1T + (size_t)t * 16 * 2048, 2048, 2048, lds, wave, lane);
            if (wave != 0) continue;
            bf16_t* dst; int ld, cc; pg8::route(C, 0, t * 16, dst, ld, cc);
#pragma unroll
            for (int j = 0; j < 4; ++j) { const int R = PADR + 4 * (lane >> 4) + j; const bf16_t v = f2bf(acc[j]); dst[(size_t)R * ld + cc + (lane & 15)] = v; dst[(size_t)(R + LP) * ld + cc + (lane & 15)] = v; }
        }
}

__device__ __forceinline__ void phase2(const Ctx& C, LAS unsigned char* lds, int tid, int lane, int wave, int bid, int G, int rep) {
    const int gw = wave * G + bid, NGW = G * 8; LAS bf16_t* xs = (LAS bf16_t*)(lds + wave * 16384); LAS int* slot = (LAS int*)(lds + 163776); (void)gw; (void)NGW; (void)xs; (void)slot;
        for (;;) { __syncthreads(); if (tid == 0) *slot = (int)atomicAdd(CTR + 0 + 8 * rep, 1u); __syncthreads(); const int it = *slot; if (it >= 2 * NCH * 6) break; prep_item<0>(C, it, tid, lds); }
        for (;;) { const int tb = wave_fetch_n(CTR + 1 + 8 * rep, 2u, lane); if (tb >= 2 * 64 * NCH) break; for (int t = tb; t < tb + 2 && t < 2 * 64 * NCH; ++t) s5_task<false>(C, t, lane, xs); }
}

__device__ __forceinline__ void phase3(const Ctx& C, LAS unsigned char* lds, int tid, int lane, int wave, int bid, int G, int rep) {
    const int gw = wave * G + bid, NGW = G * 8; LAS bf16_t* xs = (LAS bf16_t*)(lds + wave * 16384); LAS int* slot = (LAS int*)(lds + 163776); (void)gw; (void)NGW; (void)xs; (void)slot;
        constexpr int NK = 512, NS = 2 * 64 * NCH, NW3 = 32 * 193;
        for (;;) { const int t = block_fetch(CTR + 7 + 8 * rep, slot, tid); if (t >= 128) break; kvscan_wg<0>(C, t, lds, tid, lane, wave); }
        for (;;) { const int tb = wave_fetch_n(CTR + 2 + 8 * rep, 2u, lane); if (tb >= NS) break;
            for (int t = tb; t < tb + 2 && t < NS; ++t) s5_task<true>(C, t, lane, xs); }
        for (;;) { const int tb = wave_fetch_n(CTR + 16 + 8 * rep, 3u, lane); if (tb >= NW3) break;
            for (int t = tb; t < tb + 3 && t < NW3; ++t) transpose_item(C.w_in_c, 2048, 6160, W3T, (LAS float*)xs, t, lane); }
}

__device__ __forceinline__ void phase4(const Ctx& C, LAS unsigned char* lds, int tid, int lane, int wave, int bid, int G, int rep) {
    const int gw = wave * G + bid, NGW = G * 8; LAS bf16_t* xs = (LAS bf16_t*)(lds + wave * 16384); LAS int* slot = (LAS int*)(lds + 163776); (void)gw; (void)NGW; (void)xs; (void)slot;
        pg8::Gemm g{YG, WGLUT, 1024, 1024, 1024}; pg8::SubOrder S{4, bid, 128};
        pg8::EpiGLU E{C};
        pg8::gemm_phase(lds, g, S, E);
        for (int t = bid; t < 64; t += G) {
            {
                const f32x4 acc = skinny16_wg(YG + (size_t)PADR * 1024, 1024, WGLUT + (size_t)t * 16 * 1024, 1024, 1024, lds, wave, lane);
                if (wave != 0) continue;
#pragma unroll
                for (int j = 0; j < 4; ++j) { const int R = PADR + 4 * (lane >> 4) + j, col = t * 16 + (lane & 15);
                    const float y = bf2f(YG[(size_t)R * 1024 + col]), z = bf2f(ZB0[(size_t)R * 1024 + col]); const bf16_t o = f2bf(y * sigmoidf_(acc[j]) * siluf_(z));
                    YCAT[(size_t)R * 3072 + 2048 + col] = o; YCAT[(size_t)(R + LP) * 3072 + 2048 + col] = o; }
            }
        }
        for (;;) { const int t = block_fetch(CTR + 3 + 8 * rep, slot, tid); if (t >= 16 * NCH) break; mixout_wg<0>(C, t, lds, tid, lane, wave); }
}

__device__ __forceinline__ void phase6(const Ctx& C, LAS unsigned char* lds, int tid, int lane, int wave, int bid, int G, int rep) {
    const int gw = wave * G + bid, NGW = G * 8; LAS bf16_t* xs = (LAS bf16_t*)(lds + wave * 16384); LAS int* slot = (LAS int*)(lds + 163776); (void)gw; (void)NGW; (void)xs; (void)slot;
        pg8::Gemm g{A1, W3T, 2048, 2048, 2048}; pg8::StaticOrder S; S.init(8192, 6144, G, bid);
        pg8::EpiProj<1> E{C};
        pg8::gemm_phase(lds, g, S, E);
        for (int t = bid; t < 514 + 192; t += G) {
            if (t < 514) {
                const int b = t / 257, Rb = b * LP + PADR + (t % 257) * 16;
                const f32x4 acc = skinny16_wg(A1 + (size_t)Rb * 2048, 2048, W3T + (size_t)6144 * 2048, 2048, 2048, lds, wave, lane);
                if (wave != 0) continue;
#pragma unroll
                for (int j = 0; j < 4; ++j) { const int R = Rb + 4 * (lane >> 4) + j; GLOW[(size_t)R * 16 + (lane & 15)] = acc[j] * rsqrtf(SSQ1[R] * (1.f / 2048.f) + EPS); }
            } else {
                const int c3 = 1024 + (t - 514) * 16;
                const f32x4 acc = skinny16_wg(A1 + (size_t)PADR * 2048, 2048, W3T + (size_t)c3 * 2048, 2048, 2048, lds, wave, lane);
                if (wave != 0) continue;
                bf16_t* dst; int ld, cc; pg8::route(C, 1, c3, dst, ld, cc);
#pragma unroll
                for (int j = 0; j < 4; ++j) { const int R = PADR + 4 * (lane >> 4) + j; const bf16_t v = f2bf(acc[j] * rsqrtf(SSQ1[R] * (1.f / 2048.f) + EPS));
                    dst[(size_t)R * ld + cc + (lane & 15)] = v; dst[(size_t)(R + LP) * ld + cc + (lane & 15)] = v; }
            }
        }
}

__device__ __forceinline__ void phase7(const Ctx& C, LAS unsigned char* lds, int tid, int lane, int wave, int bid, int G, int rep) {
    const int gw = wave * G + bid, NGW = G * 8; LAS bf16_t* xs = (LAS bf16_t*)(lds + wave * 16384); LAS int* slot = (LAS int*)(lds + 163776); (void)gw; (void)NGW; (void)xs; (void)slot;
        for (;;) { __syncthreads(); if (tid == 0) *slot = (int)atomicAdd(CTR + 4 + 8 * rep, 1u); __syncthreads(); const int it = *slot; if (it >= 2 * NCH * 6) break; prep_item<1>(C, it, tid, lds); }
}

#define XB_TMO      128
#define XB_XCNT(j)  (256  + 64 * (j))
#define XB_XSUB(j)  (1280 + 64 * (j))
#define XB_XGEN(j)  (2304 + 64 * (j))
#define XB_TOP      3328
#define XB_TOPGEN   3392
#define XCD_BAR_WORDS 3456
#define XB_SPIN_CAP (1u << 22)
constexpr size_t M_BAR = 7340032;
__device__ __forceinline__ unsigned xb_ld(unsigned* p)              { return __hip_atomic_load(p, __ATOMIC_RELAXED, __HIP_MEMORY_SCOPE_AGENT); }
__device__ __forceinline__ unsigned xb_add(unsigned* p, unsigned v) { return __hip_atomic_fetch_add(p, v, __ATOMIC_RELAXED, __HIP_MEMORY_SCOPE_AGENT); }
__device__ __forceinline__ unsigned xb_xcc_id() { return (unsigned)__builtin_amdgcn_s_getreg((3 << 11) | 20) & 0xFu; }
#define XB_SPIN(cond, bar) do { unsigned _sp = 0; while (cond) { __builtin_amdgcn_s_sleep(1); \
    if ((++_sp & 255u) == 0u) { if (xb_ld(&(bar)[XB_TMO])) break; if (_sp > XB_SPIN_CAP) { atomicAdd(&(bar)[XB_TMO], 1u); break; } } } } while (0)
struct XcdBarrier { unsigned* bar; unsigned x; volatile LAS unsigned* st; };
__device__ __forceinline__ XcdBarrier xcd_barrier_post(unsigned* bar, volatile LAS unsigned* st) {
    XcdBarrier b; b.bar = bar; b.x = xb_xcc_id(); b.st = st;
    if (threadIdx.x == 0) (void)xb_add(&bar[XB_XCNT(b.x)], 1u);
    return b;
}
__device__ __forceinline__ void xcd_barrier_complete(unsigned* bar, unsigned x, unsigned& nloc, unsigned& nx) {
    const unsigned G = gridDim.x * gridDim.y * gridDim.z;
    unsigned sum, cnt, mine, sp = 0u;
    for (;;) {
        sum = 0u; cnt = 0u; mine = 0u;
#pragma unroll
        for (unsigned j = 0; j < 16; ++j) { const unsigned c = xb_ld(&bar[XB_XCNT(j)]); sum += c; cnt += (c > 0u) ? 1u : 0u; mine = (j == x) ? c : mine; }
        if (sum == G) break;
        __builtin_amdgcn_s_sleep(1);
        if ((++sp & 255u) == 0u) { if (xb_ld(&bar[XB_TMO])) break; if (sp > XB_SPIN_CAP) { atomicAdd(&bar[XB_TMO], 1u); break; } }
    }
    nloc = mine > 0u ? mine : 1u; nx = cnt > 0u ? cnt : 1u;
}
__device__ __forceinline__ void xcd_barrier(const XcdBarrier& b) {
    asm volatile("s_waitcnt vmcnt(0)" ::: "memory");
    __syncthreads();
    if (threadIdx.x == 0) {
        unsigned* bar = b.bar;
        __builtin_amdgcn_s_waitcnt(0);
        unsigned nloc = b.st[0], nx = b.st[1];
        if (nloc == 0u) { xcd_barrier_complete(bar, b.x, nloc, nx); b.st[0] = nloc; b.st[1] = nx; }
        const unsigned old = xb_add(&bar[XB_XSUB(b.x)], 1u);
        const unsigned gen = old / nloc;
        if (old + 1u == (gen + 1u) * nloc) {
            __builtin_amdgcn_fence(__ATOMIC_RELEASE, "agent");
            asm volatile("s_waitcnt vmcnt(0)" ::: "memory");
            const unsigned og = xb_add(&bar[XB_TOP], 1u);
            const unsigned tg = og / nx;
            if (og + 1u == (tg + 1u) * nx) xb_add(&bar[XB_TOPGEN], 1u);
            else XB_SPIN(xb_ld(&bar[XB_TOPGEN]) == tg, bar);
            __builtin_amdgcn_fence(__ATOMIC_ACQUIRE, "agent");
            xb_add(&bar[XB_XGEN(b.x)], 1u);
            asm volatile("s_waitcnt vmcnt(0)" ::: "memory");
        } else {
            XB_SPIN(xb_ld(&bar[XB_XGEN(b.x)]) == gen, bar);
            __builtin_amdgcn_fence(__ATOMIC_ACQUIRE, "agent");
            asm volatile("s_waitcnt vmcnt(0)" ::: "memory");
        }
    }
    __syncthreads();
}

__global__ void __launch_bounds__(512, 2) fwd(Ctx C) {
    extern __shared__ __attribute__((aligned(16))) unsigned char lds_raw[];
    LAS unsigned char* lds = (LAS unsigned char*)lds_raw;
    cg::grid_group grid = cg::this_grid();
    const int tid = threadIdx.x, lane = tid & 63, wave = __builtin_amdgcn_readfirstlane(tid >> 6), bid = blockIdx.x, G = gridDim.x;
    const int gw = wave * G + bid, NGW = G * 8;
    LAS bf16_t* xs = (LAS bf16_t*)(lds + wave * 16384);
    LAS int* slot = (LAS int*)(lds + 163776);
    const int lo = C.ph_lo, hi = C.ph_hi;
#define IN(k) (lo <= (k) && (k) < hi)
#define REPK(k) ((REP_MASK >> (k)) & 1)
#define REPLOOP(k) for (int rep = 0; rep <= REPK(k); ++rep)
#define REPSYNC(k) do { if (rep < REPK(k)) grid.sync(); } while (0)
#ifdef PROBE_A
    unsigned long long* STAMP = (unsigned long long*)WSB(MISC + 7000000);
#define STAMPIT(k) do { if (bid == 0 && tid == 0) STAMP[k] = __builtin_amdgcn_s_memrealtime(); } while (0)
#else
#define STAMPIT(k) do {} while (0)
#endif
    volatile LAS unsigned* bst = (volatile LAS unsigned*)(lds + 163792);
    if (tid < 2) bst[tid] = 0u;
    __syncthreads();
    XcdBarrier xbar = xcd_barrier_post((unsigned*)WSB(MISC + M_BAR), bst);
    if (C.ph_hi > 1000) grid.sync();
#define SEAM(k) do { if (IN(k) && IN((k) + 1)) xcd_barrier(xbar); STAMPIT((k) + 1); } while (0)
    STAMPIT(0);

    if (IN(0)) { p0_phase(C, lds, tid, lane, wave, bid, G); if (REPK(0)) { xcd_barrier(xbar); p0_phase(C, lds, tid, lane, wave, bid, G); } }
    SEAM(0);
    if (IN(1)) { phase1(C, lds, tid, lane, wave, bid, G, 0); if (REPK(1)) { xcd_barrier(xbar); phase1(C, lds, tid, lane, wave, bid, G, 1); } }
    SEAM(1);
    if (IN(2)) { phase2(C, lds, tid, lane, wave, bid, G, 0); if (REPK(2)) { xcd_barrier(xbar); phase2(C, lds, tid, lane, wave, bid, G, 1); } }
    SEAM(2);
    if (IN(3)) { phase3(C, lds, tid, lane, wave, bid, G, 0); if (REPK(3)) { xcd_barrier(xbar); phase3(C, lds, tid, lane, wave, bid, G, 1); } }
    SEAM(3);
    if (IN(4)) { phase4(C, lds, tid, lane, wave, bid, G, 0); if (REPK(4)) { xcd_barrier(xbar); phase4(C, lds, tid, lane, wave, bid, G, 1); } }
    SEAM(4);
    if (IN(5)) {
        pg8::Gemm g{YCAT, WO1T, 3072, 3072, 3072}; pg8::StaticOrder S; S.init(8192, 2048, G, bid);
        pg8::EpiOut<0> E{C};
        pg8::gemm_phase(lds, g, S, E);
        for (int t = bid; t < 128; t += G) {
            const f32x4 acc = skinny16_wg(YCAT + (size_t)PADR * 3072, 3072, WO1T + (size_t)t * 16 * 3072, 3072, 3072, lds, wave, lane);
            if (wave != 0) continue;
            const int col = t * 16 + (lane & 15); const float w = C.norm_c_w[col];
#pragma unroll
            for (int j = 0; j < 4; ++j) { const int mr = 4 * (lane >> 4) + j; const float hv = C.meta[(size_t)mr * DM + col] + acc[j];
                const bf16_t o = f2bf(hv * w); A1[(size_t)(PADR + mr) * DM + col] = o; A1[(size_t)(LP + PADR + mr) * DM + col] = o;
                float s = hv * hv; s += __shfl_xor(s, 1); s += __shfl_xor(s, 2); s += __shfl_xor(s, 4); s += __shfl_xor(s, 8);
                if ((lane & 15) == 0) { unsafeAtomicAdd(SSQ1 + PADR + mr, s); unsafeAtomicAdd(SSQ1 + LP + PADR + mr, s); } }
        }
    }
    SEAM(5);
    if (IN(6)) { phase6(C, lds, tid, lane, wave, bid, G, 0); if (REPK(6)) { xcd_barrier(xbar); phase6(C, lds, tid, lane, wave, bid, G, 1); } }
    SEAM(6);
    if (IN(7)) { phase7(C, lds, tid, lane, wave, bid, G, 0); if (REPK(7)) { xcd_barrier(xbar); phase7(C, lds, tid, lane, wave, bid, G, 1); } }
    SEAM(7);
    if (IN(8)) { for (;;) { const int t = block_fetch(CTR + 5, slot, tid); if (t >= 128) break; kvscan_wg<1>(C, t, lds, tid, lane, wave); } if (REPK(8)) { xcd_barrier(xbar); for (;;) { const int t = block_fetch(CTR + 13, slot, tid); if (t >= 128) break; kvscan_wg<1>(C, t, lds, tid, lane, wave); } } }
    SEAM(8);
    if (IN(9)) { for (;;) { const int t = block_fetch(CTR + 6, slot, tid); if (t >= 8 * 32) break; mixout_wg<1>(C, t, lds, tid, lane, wave); } if (REPK(9)) { xcd_barrier(xbar); for (;;) { const int t = block_fetch(CTR + 14, slot, tid); if (t >= 8 * 32) break; mixout_wg<1>(C, t, lds, tid, lane, wave); } } }
    SEAM(9);
    if (IN(10)) {
        pg8::Gemm g{Y1, WO2T, 2048, 2048, 2048}; pg8::StaticOrder S; S.init(8192, 2048, G, bid);
        pg8::EpiOut<1> E{C};
        pg8::gemm_phase(lds, g, S, E);
    }
    SEAM(10);
#ifdef EXTRA_SYNCS
    for (int q = 0; q < EXTRA_SYNCS; ++q) grid.sync();
#endif
    if (IN(11)) {
        for (int r = gw; r < 8192; r += NGW) {
            const float rstd = rsqrtf(SSQ2[r] * (1.f / 2048.f) + EPS);
            float* row = C.out + (size_t)r * DM;
#pragma unroll
            for (int j = 0; j < 8; ++j) { const int c = (lane + 64 * j) * 4; const f32x4 v = *(const f32x4*)(row + c), w = *(const f32x4*)(C.final_w + c); *(f32x4*)(row + c) = v * rstd * w; }
        }
    }
#ifdef PROBE_A
    grid.sync();
    if (bid == 0) {
        if (tid == 0) STAMP[12] = __builtin_amdgcn_s_memrealtime();
        __syncthreads();
        const float da = (float)(STAMP[PROBE_A + 1] - STAMP[PROBE_A]) * 0.01f, db = (float)(STAMP[PROBE_B + 1] - STAMP[PROBE_B]) * 0.01f;
        if (tid == 0) C.out[0] = da;
        for (int i = 1048576 + tid; i < 2097152; i += 512) C.out[i] += db * 0.01f;
    }
#endif
#undef IN
#undef SEAM
}

__global__ void dump_k(const bf16_t* src, float* out, int n) { for (int i = blockIdx.x * blockDim.x + threadIdx.x; i < n; i += gridDim.x * blockDim.x) { if (i < 8650752) { const int row = i / 2048; out[i] = (row >= 128 && row < 4096) ? bf2f(src[(size_t)row * 3072 + (i % 2048)]) : 0.f; } } }
extern "C" void kernel_launch(void* const* d_in, const int* in_sizes, int n_in, void* d_out, int out_size, void* d_ws, size_t ws_size, hipStream_t stream) {
    static int ready = 0;
    if (!ready) {
        if (hipFuncSetAttribute((const void*)fwd, hipFuncAttributeMaxDynamicSharedMemorySize, LDS_BYTES) != hipSuccess) fprintf(stderr, "kernel_launch: hipFuncSetAttribute failed\n");
        ready = 1;
    }
    Ctx c{};
    const float** p = (const float**)&c;
    for (int i = 0; i < 22; ++i) p[i] = (const float*)d_in[i];
    c.out = (float*)d_out; c.ws = (unsigned char*)d_ws;
#ifdef MK_MULTI
    hipMemsetAsync(d_ws, 0, 268435456, stream); hipMemsetAsync(d_out, 0, (size_t)out_size * 4, stream);
    for (int ph = 0; ph < RUN_PH; ++ph) { c.ph_lo = ph; c.ph_hi = ph + 1; hipLaunchKernelGGL(fwd, dim3(256), dim3(512), LDS_BYTES, stream, c); }
#ifdef DUMP_SLOT
    hipLaunchKernelGGL(dump_k, dim3(2048), dim3(256), 0, stream, (const bf16_t*)((unsigned char*)d_ws + (size_t)DUMP_SLOT * SLOT), (float*)d_out, out_size);
#endif
#else
    c.ph_lo = 0; c.ph_hi = NPHASE;
    (void)hipMemsetAsync((unsigned char*)d_ws + MISC + M_BAR, 0, 16384, stream);
    void* args[] = {&c};
    hipError_t e = hipLaunchCooperativeKernel((const void*)fwd, dim3(256), dim3(512), args, LDS_BYTES, stream);
    if (e != hipSuccess) fprintf(stderr, "cooperative launch failed: %s\n", hipGetErrorString(e));
#endif
}
```

```cpp
#define RUN_PH NPHASE
#define REP_MASK 0
#define DBG_INTER 1
#define DBG_NORM 1
#include <hip/hip_runtime.h>
#include <hip/hip_cooperative_groups.h>
#include <cstdio>
#include <cstdint>
namespace cg = cooperative_groups;

#define LAS __attribute__((address_space(3)))
typedef unsigned short bf16_t;
typedef short bf16x8 __attribute__((ext_vector_type(8)));
typedef float f32x4 __attribute__((ext_vector_type(4)));
typedef float f32x2 __attribute__((ext_vector_type(2)));
typedef unsigned u32x4 __attribute__((ext_vector_type(4)));
typedef unsigned u32x2 __attribute__((ext_vector_type(2)));

constexpr int DM = 2048, SEQ = 4096, LP = 4224, NR = 2 * LP, NCH = 33, PADR = 112;
constexpr float EPS = 1e-6f;
constexpr size_t SLOT = (size_t)NR * 1024 * 2;
constexpr size_t MISC = 15 * SLOT;
constexpr size_t M_CTR = 0, M_SSQ1 = 1024, M_SSQ2 = 34816, M_ROPE = 131072, M_S5AB = 2359296, M_S5A128 = M_S5AB + 32768,
                 M_S5BB = 2424832, M_S5C = 2949120, M_S5E = 3211264, M_DEC1 = 5373952, M_GLOW = 5644288, M_S5BBT = 6184960;
constexpr int LDS_BYTES = 163840;
constexpr int NPHASE = 12;

struct Ctx {
    const float *x, *meta, *norm_ab_w, *w_in_ab, *ret_norm_w, *lam_re, *lam_im, *log_dt, *b_re, *b_im, *c_re, *c_im, *s5d, *w_glu, *w_out_ab,
        *norm_c_w, *w_in_c, *w_gate, *b_gate, *gla_norm_w, *w_out_c, *final_w;
    float* out; unsigned char* ws; int ph_lo, ph_hi;
};

#define WSB(off) (C.ws + (off))
#define SL(i) ((bf16_t*)(C.ws + (size_t)(i) * SLOT))
#define W1T SL(0)
#define WO1T SL(2)
#define U0 SL(3)
#define Q0RAW SL(4)
#define K0RAW SL(5)
#define V0RAW SL(6)
#define ZA0 SL(8)
#define ZB0 SL(10)
#define WGLUT SL(11)
#define WO2T ((bf16_t*)(C.ws + 11 * SLOT + 2097152))
#define KD0 SL(12)
#define KT0 SL(13)
#define YG SL(14)
#define A0 ((bf16_t*)C.out)
#define VT0 ((bf16_t*)C.out)
#define QD0 ((bf16_t*)((unsigned char*)C.out + 2 * SLOT))
#define SP0 SL(0)
#define YCAT SL(3)
#define W3T SL(6)
#define A1 SL(0)
#define Q1RAW SL(3)
#define K1RAW SL(4)
#define V1RAW SL(8)
#define Z1 SL(12)
#define QD1 SL(5)
#define KD1 SL(10)
#define KT1 SL(14)
#define VT1 SL(0)
#define SP1 SL(6)
#define Y1 SL(3)
#define CTR ((unsigned*)WSB(MISC + M_CTR))
#define SSQ1 ((float*)WSB(MISC + M_SSQ1))
#define SSQ2 ((float*)WSB(MISC + M_SSQ2))
#define ROPE ((f32x2*)WSB(MISC + M_ROPE))
#define S5AB ((f32x2*)WSB(MISC + M_S5AB))
#define S5A128 ((f32x2*)WSB(MISC + M_S5A128))
#define S5BB ((float*)WSB(MISC + M_S5BB))
#define S5C ((bf16_t*)WSB(MISC + M_S5C))
#define S5E ((float*)WSB(MISC + M_S5E))
#define DEC1 ((float*)WSB(MISC + M_DEC1))
#define GLOW ((float*)WSB(MISC + M_GLOW))
#define S5BBT ((bf16_t*)WSB(MISC + M_S5BBT))

#define LDS_FENCE() asm volatile("s_waitcnt lgkmcnt(0)" ::: "memory")
#define LBAR() do { asm volatile("s_waitcnt lgkmcnt(0)" ::: "memory"); __builtin_amdgcn_s_barrier(); asm volatile("" ::: "memory"); } while (0)
typedef __bf16 bf16v2_t __attribute__((ext_vector_type(2)));
__device__ __forceinline__ unsigned cvt_pk_bf16(float lo, float hi) { bf16v2_t v; v.x = (__bf16)lo; v.y = (__bf16)hi; return __builtin_bit_cast(unsigned, v); }
__device__ __forceinline__ bf16_t f2bf(float f) { return (bf16_t)(cvt_pk_bf16(f, 0.f) & 0xffffu); }
__device__ __forceinline__ float bf2f(bf16_t h) { return __uint_as_float(((unsigned)h) << 16); }
__device__ __forceinline__ float bflo(unsigned w) { return __uint_as_float(w << 16); }
__device__ __forceinline__ float bfhi(unsigned w) { return __uint_as_float(w & 0xffff0000u); }
__device__ __forceinline__ float wave_sum(float v) {
#pragma unroll
    for (int o = 1; o < 64; o <<= 1) v += __shfl_xor(v, o);
    return v;
}
__device__ __forceinline__ float sigmoidf_(float x) { return 1.f / (1.f + __expf(-x)); }
__device__ __forceinline__ float siluf_(float x) { return x / (1.f + __expf(-x)); }
__device__ __forceinline__ float gelu_tanh(float x) { const float t = 0.7978845608028654f * (x + 0.044715f * x * x * x); const float th = 1.f - 2.f / (__expf(2.f * t) + 1.f); return 0.5f * x * (1.f + th); }
__device__ __forceinline__ f32x4 mfma16(bf16x8 a, bf16x8 b, f32x4 c) { return __builtin_amdgcn_mfma_f32_16x16x32_bf16(a, b, c, 0, 0, 0); }
__device__ __forceinline__ void gstore16_hidden(void* p, u32x4 v) { asm volatile("global_store_dwordx4 %0, %1, off" :: "v"(p), "v"(v) : "memory"); }
__device__ __forceinline__ void gstore8_hidden(void* p, u32x2 v) { asm volatile("global_store_dwordx2 %0, %1, off" :: "v"(p), "v"(v) : "memory"); }
__device__ __forceinline__ int wave_fetch_n(unsigned* ctr, unsigned nb, int lane) { unsigned v = 0; if (lane == 0) v = atomicAdd(ctr, nb); return (int)__builtin_amdgcn_readfirstlane(v); }
__device__ __forceinline__ int wave_fetch(unsigned* ctr, int lane) { unsigned v = 0; if (lane == 0) v = atomicAdd(ctr, 1u); return (int)__builtin_amdgcn_readfirstlane(v); }
__device__ __forceinline__ void dsincos(double x, double& s, double& c) {
    const double q = rint(x * 0.6366197723675814);
    double r = fma(-q, 1.5707963267948966, x); r = fma(-q, 6.123233995736766e-17, r);
    const int iq = ((int)q) & 3; const double r2 = r * r;
    const double sp = r * (1.0 + r2 * (-1.0 / 6 + r2 * (1.0 / 120 + r2 * (-1.0 / 5040 + r2 * (1.0 / 362880 + r2 * (-1.0 / 39916800 + r2 * (1.0 / 6227020800.0)))))));
    const double cp = 1.0 + r2 * (-0.5 + r2 * (1.0 / 24 + r2 * (-1.0 / 720 + r2 * (1.0 / 40320 + r2 * (-1.0 / 3628800 + r2 * (1.0 / 479001600.0 + r2 * (-1.0 / 87178291200.0)))))));
    s = (iq == 0) ? sp : (iq == 1) ? cp : (iq == 2) ? -sp : -cp;
    c = (iq == 0) ? cp : (iq == 1) ? -sp : (iq == 2) ? -cp : sp;
}

namespace pg8 {
constexpr int BM = 256, BK = 64, HALF = 128, HTB = HALF * BK * 2, STAGE_BYTES = 8 * HTB, NXCD = 8, WGM = 8;
__host__ __device__ __forceinline__ int lds_byte(int r, int c) { const int st = (r >> 4) * 2 + (c >> 5), rr = r & 15, cc = c & 31, ob = rr * 64 + cc * 2; return st * 1024 + (ob ^ (((ob >> 9) & 1) << 5)); }
__host__ __device__ __forceinline__ void stage_rc(int b, int& R, int& Cc) { const int st = b / 1024, sb = b % 1024, swz = sb ^ (((sb >> 9) & 1) << 5); R = (st >> 1) * 16 + swz / 64; Cc = (st & 1) * 32 + (swz % 64) / 2; }
__host__ __device__ __forceinline__ int perm32(int rho) { const int n = rho >> 4, i = rho & 15; return 8 * (i >> 2) + 4 * n + (i & 3); }
struct Unit { int pm, pn; };
struct Gemm { const bf16_t* A; const bf16_t* Bt; int lda, ldb, K; };
__device__ __forceinline__ int arow(int pm) { return (pm >> 4) * LP + 128 + (pm & 15) * 256; }
struct StaticOrder {
    int nM, nN, nwg, G, c;
    __device__ void init(int M, int N, int G_, int c_) { nM = M / BM; nN = N / BM; nwg = nM * nN; G = G_; c = c_; }
    __device__ bool next(int i, Unit& u) const {
        const long L = (long)i * G + c; if (L >= nwg) return false;
        int wgid = (int)L; { const int q = nwg / NXCD, r = nwg % NXCD, xcd = wgid % NXCD, off = wgid / NXCD; wgid = (xcd < r ? xcd * (q + 1) : r * (q + 1) + (xcd - r) * q) + off; }
        const int nig = WGM * nN, gid = wgid / nig, fm = gid * WGM, gsz = (nM - fm) < WGM ? (nM - fm) : WGM;
        u.pm = fm + ((wgid % nig) % gsz); u.pn = (wgid % nig) / gsz; return true;
    }
};
struct SubOrder {
    int nN, c, nunits;
    __device__ bool next(int i, Unit& u) const { if (i > 0 || c >= nunits) return false; u.pm = c / nN; u.pn = c % nN; return true; }
};

template <class Epi, class Sched>
__device__ __forceinline__ void gemm_phase(LAS unsigned char* lds, const Gemm g, const Sched& S, const Epi& E) {
    const int tid = threadIdx.x, wid = __builtin_amdgcn_readfirstlane(tid >> 6), lane = tid & 63, wr = wid >> 2, wc = wid & 3, fr = lane & 15, fq = lane >> 4;
    const int K = g.K, nt = K / BK;
    unsigned voffA[2], voffB[2];
#pragma unroll
    for (int i = 0; i < 2; ++i) { int R, Cc; stage_rc(tid * 16 + i * 8192, R, Cc); const int Rb = (R & ~31) + perm32(R & 31);
        voffA[i] = (unsigned)(R * g.lda + Cc) * 2u; voffB[i] = (unsigned)(Rb * g.ldb + Cc) * 2u; }
    const size_t kstep = (size_t)(BK * 2);
    const size_t hA = (size_t)HALF * g.lda * 2, hB = (size_t)HALF * g.ldb * 2;
    const unsigned ldsw = (unsigned)wid * 1024u;
    const int aoff = lds_byte(wr * 64 + fr, fq * 8), boff = lds_byte(wc * 32 + fr, fq * 8);
#define PG8_SA(b, h) (((b) * 2 + (h)) * HTB)
#define PG8_SB(b, h) ((4 + (b) * 2 + (h)) * HTB)
#define PG8_STAGE(bufoff, gbase, voff) do { _Pragma("unroll") for (int _i = 0; _i < 2; ++_i) \
        __builtin_amdgcn_global_load_lds((const unsigned*)((const char*)(gbase) + (voff)[_i]), (LAS unsigned*)(lds + (bufoff) + ldsw + _i * 8192), 16, 0, 0); } while (0)
#define PG8_LDA(dst, b, h) do { _Pragma("unroll") for (int m = 0; m < 4; ++m) _Pragma("unroll") for (int k = 0; k < 2; ++k) dst[m][k] = *(const LAS bf16x8*)(lds + PG8_SA(b, h) + aoff + m * 2048 + k * 1024); } while (0)
#define PG8_LDB(dst, b, h) do { _Pragma("unroll") for (int n = 0; n < 2; ++n) _Pragma("unroll") for (int k = 0; k < 2; ++k) dst[n][k] = *(const LAS bf16x8*)(lds + PG8_SB(b, h) + boff + n * 2048 + k * 1024); } while (0)
#define PG8_MMA(ai, bj, At, Bt) do { __builtin_amdgcn_s_setprio(1); _Pragma("unroll") for (int m = 0; m < 4; ++m) _Pragma("unroll") for (int n = 0; n < 2; ++n) _Pragma("unroll") for (int k = 0; k < 2; ++k) \
        acc[ai][bj][m][n] = __builtin_amdgcn_mfma_f32_16x16x32_bf16(Bt[n][k], At[m][k], acc[ai][bj][m][n], 0, 0, 0); __builtin_amdgcn_s_setprio(0); } while (0)
#define PG8_WAIT_V(n) asm volatile("s_waitcnt vmcnt(" #n ")" ::: "memory")
#define PG8_WAIT_L(n) asm volatile("s_waitcnt lgkmcnt(" #n ")" ::: "memory")
#define PG8_BAR __builtin_amdgcn_s_barrier()
#define PG8_SCHED __builtin_amdgcn_sched_barrier(0)
    Unit cur, nxt; int ui = 0;
    if (!S.next(0, cur)) return;
    f32x4 acc[2][2][4][2];
#pragma unroll
    for (int a = 0; a < 2; ++a)
#pragma unroll
        for (int b = 0; b < 2; ++b)
#pragma unroll
            for (int m = 0; m < 4; ++m)
#pragma unroll
                for (int n = 0; n < 2; ++n) acc[a][b][m][n] = (f32x4){0.f, 0.f, 0.f, 0.f};
    bf16x8 At[4][2], B0[2][2], B1[2][2];
    const char* cA = (const char*)g.A + (size_t)arow(cur.pm) * g.lda * 2; const char* cB = (const char*)g.Bt + (size_t)cur.pn * 256 * g.ldb * 2;
    PG8_STAGE(PG8_SB(0, 0), cB, voffB); PG8_STAGE(PG8_SB(0, 1), cB + hB, voffB); PG8_STAGE(PG8_SA(0, 0), cA, voffA); PG8_STAGE(PG8_SA(0, 1), cA + hA, voffA);
    if (wr == 1) PG8_BAR;
    PG8_WAIT_V(2); PG8_BAR;
    PG8_STAGE(PG8_SB(1, 0), cB + kstep, voffB); PG8_STAGE(PG8_SA(1, 0), cA + kstep, voffA); PG8_STAGE(PG8_SB(1, 1), cB + hB + kstep, voffB);
    PG8_WAIT_V(6); PG8_BAR;
    for (;;) {
        const bool has_next = S.next(ui + 1, nxt);
        const char* nA = has_next ? (const char*)g.A + (size_t)arow(nxt.pm) * g.lda * 2 : cA; const char* nB = has_next ? (const char*)g.Bt + (size_t)nxt.pn * 256 * g.ldb * 2 : cB;
        for (int t = 0; t < nt; t += 2) {
            const bool last = (t == nt - 2);
            const char* a1 = cA + (size_t)(t + 1) * kstep;
            const char* a2 = last ? nA : cA + (size_t)(t + 2) * kstep; const char* b2 = last ? nB : cB + (size_t)(t + 2) * kstep;
            const char* a3 = a2 + kstep; const char* b3 = b2 + kstep;
            PG8_LDB(B0, 0, 0); PG8_LDB(B1, 0, 1); PG8_SCHED; PG8_LDA(At, 0, 0); PG8_STAGE(PG8_SA(1, 1), a1 + hA, voffA);
            PG8_WAIT_V(8); PG8_WAIT_L(0); PG8_BAR; PG8_MMA(0, 0, At, B0); PG8_MMA(0, 1, At, B1); PG8_BAR; PG8_SCHED;
            PG8_LDA(At, 0, 1); PG8_STAGE(PG8_SB(0, 0), b2, voffB); PG8_STAGE(PG8_SB(0, 1), b2 + hB, voffB); PG8_STAGE(PG8_SA(0, 0), a2, voffA);
            PG8_WAIT_V(8); PG8_WAIT_L(0); PG8_BAR; PG8_MMA(1, 0, At, B0); PG8_MMA(1, 1, At, B1); PG8_BAR; PG8_SCHED;
            PG8_LDB(B0, 1, 0); PG8_LDB(B1, 1, 1); PG8_SCHED; PG8_LDA(At, 1, 0); PG8_STAGE(PG8_SA(0, 1), a2 + hA, voffA);
            PG8_WAIT_V(8); PG8_WAIT_L(0); PG8_BAR; PG8_MMA(0, 0, At, B0); PG8_MMA(0, 1, At, B1); PG8_BAR; PG8_SCHED;
            PG8_LDA(At, 1, 1); PG8_STAGE(PG8_SB(1, 0), b3, voffB); PG8_STAGE(PG8_SB(1, 1), b3 + hB, voffB); PG8_STAGE(PG8_SA(1, 0), a3, voffA);
            PG8_WAIT_V(8); PG8_WAIT_L(0); PG8_BAR; PG8_MMA(1, 0, At, B0); PG8_MMA(1, 1, At, B1); PG8_BAR; PG8_SCHED;
        }
        if (wr == 0) PG8_BAR;
        E(acc, cur, wr, wc, fr, fq);
        if (!has_next) break;
#pragma unroll
        for (int a = 0; a < 2; ++a)
#pragma unroll
            for (int b = 0; b < 2; ++b)
#pragma unroll
                for (int m = 0; m < 4; ++m)
#pragma unroll
                    for (int n = 0; n < 2; ++n) acc[a][b][m][n] = (f32x4){0.f, 0.f, 0.f, 0.f};
        cur = nxt; cA = nA; cB = nB; ++ui;
        if (wr == 1) PG8_BAR;
    }
    PG8_WAIT_V(0);
    PG8_BAR;
#undef PG8_SA
#undef PG8_SB
#undef PG8_STAGE
#undef PG8_LDA
#undef PG8_LDB
#undef PG8_MMA
#undef PG8_WAIT_V
#undef PG8_WAIT_L
#undef PG8_BAR
#undef PG8_SCHED
}
typedef f32x4 Acc[2][2][4][2];

__device__ __forceinline__ void route(const Ctx& C, int layer, int c0, bf16_t*& dst, int& ld, int& cc) {
    if (layer == 0) {
        if (c0 < 1024) { dst = Q0RAW; ld = 1024; cc = c0; } else if (c0 < 2048) { dst = K0RAW; ld = 1024; cc = c0 - 1024; }
        else if (c0 < 4096) { dst = V0RAW; ld = 2048; cc = c0 - 2048; } else if (c0 < 6144) { dst = ZA0; ld = 2048; cc = c0 - 4096; }
        else if (c0 < 7168) { dst = U0; ld = 1024; cc = c0 - 6144; } else { dst = ZB0; ld = 1024; cc = c0 - 7168; }
    } else {
        if (c0 < 1024) { dst = Q1RAW; ld = 1024; cc = c0; } else if (c0 < 2048) { dst = K1RAW; ld = 1024; cc = c0 - 1024; }
        else if (c0 < 4096) { dst = V1RAW; ld = 2048; cc = c0 - 2048; } else { dst = Z1; ld = 2048; cc = c0 - 4096; }
    }
}
template <int LAYER> struct EpiProj {
    Ctx C;
    __device__ __forceinline__ void operator()(const Acc& acc, const Unit& u, int wr, int wc, int fr, int fq) const {
        bf16_t* dst; int ld, c0; route(C, LAYER, u.pn * 256, dst, ld, c0);
        const int rbase = arow(u.pm);
#pragma unroll
        for (int ai = 0; ai < 2; ++ai)
#pragma unroll
            for (int m = 0; m < 4; ++m) {
                const int R = rbase + ai * 128 + wr * 64 + m * 16 + fr;
                float sc = 1.f; if (LAYER == 1) sc = rsqrtf(SSQ1[R] * (1.f / 2048.f) + EPS);
#pragma unroll
                for (int bj = 0; bj < 2; ++bj) {
                    const int cl = c0 + bj * 128 + wc * 32 + 8 * fq; const f32x4 v0 = acc[ai][bj][m][0] * sc, v1 = acc[ai][bj][m][1] * sc;
                    u32x4 w; w.x = cvt_pk_bf16(v0[0], v0[1]); w.y = cvt_pk_bf16(v0[2], v0[3]); w.z = cvt_pk_bf16(v1[0], v1[1]); w.w = cvt_pk_bf16(v1[2], v1[3]);
                    *(u32x4*)(dst + (size_t)R * ld + cl) = w;
                }
            }
    }
};
struct EpiGLU {
    Ctx C;
    __device__ __forceinline__ void operator()(const Acc& acc, const Unit& u, int wr, int wc, int fr, int fq) const {
        const int rbase = arow(u.pm), c0 = u.pn * 256;
#pragma unroll
        for (int ai = 0; ai < 2; ++ai)
#pragma unroll
            for (int m = 0; m < 4; ++m) {
                const int R = rbase + ai * 128 + wr * 64 + m * 16 + fr;
#pragma unroll
                for (int bj = 0; bj < 2; ++bj) {
                    const int cl = c0 + bj * 128 + wc * 32 + 8 * fq;
                    const u32x4 yv = *(const u32x4*)(YG + (size_t)R * 1024 + cl), zv = *(const u32x4*)(ZB0 + (size_t)R * 1024 + cl);
                    const f32x4 a0 = acc[ai][bj][m][0], a1 = acc[ai][bj][m][1];
                    float o[8];
                    o[0] = bflo(yv.x) * sigmoidf_(a0[0]) * siluf_(bflo(zv.x)); o[1] = bfhi(yv.x) * sigmoidf_(a0[1]) * siluf_(bfhi(zv.x));
                    o[2] = bflo(yv.y) * sigmoidf_(a0[2]) * siluf_(bflo(zv.y)); o[3] = bfhi(yv.y) * sigmoidf_(a0[3]) * siluf_(bfhi(zv.y));
                    o[4] = bflo(yv.z) * sigmoidf_(a1[0]) * siluf_(bflo(zv.z)); o[5] = bfhi(yv.z) * sigmoidf_(a1[1]) * siluf_(bfhi(zv.z));
                    o[6] = bflo(yv.w) * sigmoidf_(a1[2]) * siluf_(bflo(zv.w)); o[7] = bfhi(yv.w) * sigmoidf_(a1[3]) * siluf_(bfhi(zv.w));
                    u32x4 w; w.x = cvt_pk_bf16(o[0], o[1]); w.y = cvt_pk_bf16(o[2], o[3]); w.z = cvt_pk_bf16(o[4], o[5]); w.w = cvt_pk_bf16(o[6], o[7]);
                    *(u32x4*)(YCAT + (size_t)R * 3072 + 2048 + cl) = w;
                }
            }
    }
};
template <int LAYER> struct EpiOut {
    Ctx C;
    __device__ __forceinline__ void operator()(const Acc& acc, const Unit& u, int wr, int wc, int fr, int fq) const {
        const int rbase = arow(u.pm);
        const float* base = (LAYER == 0) ? C.x : C.out;
#pragma unroll
        for (int ai = 0; ai < 2; ++ai)
#pragma unroll
            for (int m = 0; m < 4; ++m) {
                const int rl = ai * 128 + wr * 64 + m * 16 + fr, R = rbase + rl, xr = u.pm * 256 + rl;
                float s = 0.f;
#pragma unroll
                for (int bj = 0; bj < 2; ++bj) {
                    const int cl = u.pn * 256 + bj * 128 + wc * 32 + 8 * fq;
                    const f32x4 h0 = *(const f32x4*)(base + (size_t)xr * DM + cl) + acc[ai][bj][m][0], h1 = *(const f32x4*)(base + (size_t)xr * DM + cl + 4) + acc[ai][bj][m][1];
                    *(f32x4*)(C.out + (size_t)xr * DM + cl) = h0; *(f32x4*)(C.out + (size_t)xr * DM + cl + 4) = h1;
                    s += (h0[0] * h0[0] + h0[1] * h0[1]) + (h0[2] * h0[2] + h0[3] * h0[3]) + (h1[0] * h1[0] + h1[1] * h1[1]) + (h1[2] * h1[2] + h1[3] * h1[3]);
                    if (LAYER == 0) {
                        const f32x4 w0 = *(const f32x4*)(C.norm_c_w + cl), w1 = *(const f32x4*)(C.norm_c_w + cl + 4);
                        u32x4 w; w.x = cvt_pk_bf16(h0[0] * w0[0], h0[1] * w0[1]); w.y = cvt_pk_bf16(h0[2] * w0[2], h0[3] * w0[3]); w.z = cvt_pk_bf16(h1[0] * w1[0], h1[1] * w1[1]); w.w = cvt_pk_bf16(h1[2] * w1[2], h1[3] * w1[3]);
                        *(u32x4*)(A1 + (size_t)R * DM + cl) = w;
                    }
                }
                s += __shfl_xor(s, 16); s += __shfl_xor(s, 32);
                if (fq == 0) unsafeAtomicAdd((LAYER == 0) ? (SSQ1 + R) : (SSQ2 + xr), s);
            }
    }
};
}

__device__ __forceinline__ f32x4 skinny16(const bf16_t* Ap, int lda, const bf16_t* Bp, int ldb, int K, int lane) {
    const bf16_t* a = Ap + (size_t)(lane & 15) * lda + (lane >> 4) * 8;
    const bf16_t* b = Bp + (size_t)(lane & 15) * ldb + (lane >> 4) * 8;
    f32x4 acc = {0.f, 0.f, 0.f, 0.f};
#pragma unroll 8
    for (int k = 0; k < K; k += 32) { const bf16x8 av = *(const bf16x8*)(a + k), bv = *(const bf16x8*)(b + k); acc = mfma16(av, bv, acc); }
    return acc;
}

__device__ __forceinline__ f32x4 skinny16_wg(const bf16_t* Ap, int lda, const bf16_t* Bp, int ldb, int K, LAS unsigned char* lds, int wave, int lane) {
    const int kw = K >> 3;
    const f32x4 part = skinny16(Ap + wave * kw, lda, Bp + wave * kw, ldb, kw, lane);
    LAS f32x4* red = (LAS f32x4*)lds;
    red[wave * 64 + lane] = part;
    __syncthreads();
    f32x4 r = red[lane];
#pragma unroll
    for (int w = 1; w < 8; ++w) r += red[w * 64 + lane];
    __syncthreads();
    return r;
}

__device__ __forceinline__ void transpose_item(const float* W, int K, int N, bf16_t* WT, LAS float* scr, int item, int lane) {
    const int nblk = (N + 31) / 32, kb = item / nblk, nb = item % nblk, k0 = 64 * kb, n0 = 32 * nb;
    const int nn = n0 + (lane & 31);
#pragma unroll 8
    for (int i = 0; i < 32; ++i) { const int kk = 2 * i + (lane >> 5); scr[kk * 33 + (lane & 31)] = (nn < N) ? W[(size_t)(k0 + kk) * N + nn] : 0.f; }
    LDS_FENCE();
    const int c = lane & 7;
#pragma unroll
    for (int j = 0; j < 4; ++j) { const int n = (lane >> 3) + 8 * j; const LAS float* s = scr + (8 * c) * 33 + n;
        u32x4 o; o.x = cvt_pk_bf16(s[0 * 33], s[1 * 33]); o.y = cvt_pk_bf16(s[2 * 33], s[3 * 33]); o.z = cvt_pk_bf16(s[4 * 33], s[5 * 33]); o.w = cvt_pk_bf16(s[6 * 33], s[7 * 33]);
        if (n0 + n < N) *(u32x4*)(WT + (size_t)(n0 + n) * K + k0 + 8 * c) = o; }
    LDS_FENCE();
}

__device__ __forceinline__ void transpose_item64(const float* W, int K, int N, bf16_t* WT, LAS float* scr, int item, int lane) {
    const int nblk = N / 64, kb = item / nblk, nb = item % nblk, k0 = 64 * kb, n0 = 64 * nb;
    const float* src = W + (size_t)(k0 + (lane >> 4)) * N + n0 + (lane & 15) * 4;
#pragma unroll
    for (int i = 0; i < 16; ++i) { const f32x4 v = *(const f32x4*)(src + (size_t)(4 * i) * N); LAS float* d = scr + (4 * i + (lane >> 4)) * 65 + (lane & 15) * 4; d[0] = v[0]; d[1] = v[1]; d[2] = v[2]; d[3] = v[3]; }
    LDS_FENCE();
    const int c = lane & 7;
#pragma unroll
    for (int j = 0; j < 8; ++j) { const int n = (lane >> 3) + 8 * j; const LAS float* t = scr + (8 * c) * 65 + n;
        u32x4 o; o.x = cvt_pk_bf16(t[0 * 65], t[1 * 65]); o.y = cvt_pk_bf16(t[2 * 65], t[3 * 65]); o.z = cvt_pk_bf16(t[4 * 65], t[5 * 65]); o.w = cvt_pk_bf16(t[6 * 65], t[7 * 65]);
        *(u32x4*)(WT + (size_t)(n0 + n) * K + k0 + 8 * c) = o; }
    LDS_FENCE();
}

__device__ __forceinline__ void p0_phase(const Ctx& C, LAS unsigned char* lds, int tid, int lane, int wave, int bid, int G) {
    LAS float* scr = (LAS float*)(lds + wave * 18432);
    const int gw = wave * G + bid, NGW = G * 8;
    constexpr int I1 = (2048 / 64) * (8192 / 64), IG = (1024 / 64) * (1024 / 64), IO1 = (3072 / 64) * (2048 / 64), IO2 = (2048 / 64) * (2048 / 64);
    for (int it = gw; it < I1 + IG + IO1 + IO2; it += NGW) {
        int r = it;
        if (r < I1) { transpose_item64(C.w_in_ab, 2048, 8192, W1T, scr, r, lane); continue; } r -= I1;
        if (r < IG) { transpose_item64(C.w_glu, 1024, 1024, WGLUT, scr, r, lane); continue; } r -= IG;
        if (r < IO1) { transpose_item64(C.w_out_ab, 3072, 2048, WO1T, scr, r, lane); continue; } r -= IO1;
        transpose_item64(C.w_out_c, 2048, 2048, WO2T, scr, r, lane);
    }
    for (int idx = gw; idx < 2 * 4112; idx += NGW) {
        const int b = idx / 4112, rr = idx % 4112;
        const float* src = (rr < 16) ? (C.meta + (size_t)rr * DM) : (C.x + ((size_t)b * SEQ + (rr - 16)) * DM);
        f32x4 v[8]; float s = 0.f;
#pragma unroll
        for (int j = 0; j < 8; ++j) { v[j] = *(const f32x4*)(src + (lane + 64 * j) * 4); s += (v[j][0] * v[j][0] + v[j][1] * v[j][1]) + (v[j][2] * v[j][2] + v[j][3] * v[j][3]); }
        const float rstd = rsqrtf(wave_sum(s) * (1.f / 2048.f) + EPS);
        bf16_t* dst = A0 + (size_t)(b * LP + PADR + rr) * DM;
#pragma unroll
        for (int j = 0; j < 8; ++j) { const f32x4 w = *(const f32x4*)(C.norm_ab_w + (lane + 64 * j) * 4);
            u32x2 o; o.x = cvt_pk_bf16(v[j][0] * rstd * w[0], v[j][1] * rstd * w[1]); o.y = cvt_pk_bf16(v[j][2] * rstd * w[2], v[j][3] * rstd * w[3]);
            *(u32x2*)(dst + (lane + 64 * j) * 4) = o; }
    }
    const int gt = bid * 512 + tid, NGT = G * 512;
    for (int idx = gt; idx < 4112 * 64; idx += NGT) {
        const int pos = idx >> 6, i = idx & 63;
        const double inv = exp(-(double)i * (9.210340371976184 / 64.0)); double s, c; dsincos((double)pos * inv, s, c);
        ROPE[idx] = (f32x2){(float)c, (float)s};
    }
    for (int idx = gt; idx < 4096; idx += NGT) {
        const int g = idx >> 6;
        const double lr = C.lam_re[idx], li = C.lam_im[idx], dt = exp((double)C.log_dt[g]);
        const double mag = exp(lr * dt); double s, c; dsincos(li * dt, s, c); const double ar = mag * c, ai = mag * s;
        S5AB[idx] = (f32x2){(float)ar, (float)ai};
        double pr = ar, pi = ai;
#pragma unroll
        for (int q = 0; q < 7; ++q) { const double nr_ = pr * pr - pi * pi, ni_ = 2.0 * pr * pi; pr = nr_; pi = ni_; }
        S5A128[idx] = (f32x2){(float)pr, (float)pi};
        const double den = lr * lr + li * li, nr = ar - 1.0, ni = ai, fre = (nr * lr + ni * li) / den, fim = (ni * lr - nr * li) / den;
        for (int h = 0; h < 16; ++h) { const double br = C.b_re[idx * 16 + h], bi = C.b_im[idx * 16 + h];
            S5BB[idx * 32 + h] = (float)(fre * br - fim * bi); S5BB[idx * 32 + 16 + h] = (float)(fre * bi + fim * br);
            const int p_ = idx & 63;
            S5BBT[(g * 128 + p_) * 32 + h] = f2bf((float)(fre * br - fim * bi)); S5BBT[(g * 128 + p_) * 32 + 16 + h] = 0;
            S5BBT[(g * 128 + 64 + p_) * 32 + h] = f2bf((float)(fre * bi + fim * br)); S5BBT[(g * 128 + 64 + p_) * 32 + 16 + h] = 0; }
    }
    for (int idx = gt; idx < 65536; idx += NGT) { const int gh = idx >> 6, p = idx & 63; S5C[gh * 128 + p] = f2bf(C.c_re[idx]); S5C[gh * 128 + 64 + p] = f2bf(-C.c_im[idx]); }
    for (int idx = gt; idx < NR; idx += NGT) SSQ1[idx] = 0.f;
    for (int idx = gt; idx < 8192; idx += NGT) SSQ2[idx] = 0.f;
    if (gt < 64) CTR[gt] = 0u;
}

template <int LAYER>
__device__ __forceinline__ void prep_item(const Ctx& C, int item, int tid, LAS unsigned char* lds) {
    LAS unsigned char* tl = lds + (unsigned)tid * 272u;
    const int b = item / (NCH * 6), n = (item / 6) % NCH, part = item % 6, r0 = n * 128;
    const int npad8 = (n == 0) ? 14 : 0;
    if (part < 2) {
        const int c = part * 512 + tid;
        const bf16_t* qraw = LAYER == 0 ? Q0RAW : Q1RAW; const bf16_t* kraw = LAYER == 0 ? K0RAW : K1RAW;
        bf16_t* qd = LAYER == 0 ? QD0 : QD1; bf16_t* kd = LAYER == 0 ? KD0 : KD1; bf16_t* kt = LAYER == 0 ? KT0 : KT1;
        if (LAYER == 0) {
            const int h = c >> 7, d = c & 127, pc = c ^ 64;
            const float lg = (float)log1p(-exp2(-5.0 - (double)h));
            bf16_t qo[8] = {0, 0, 0, 0, 0, 0, 0, 0}, ko[8] = {0, 0, 0, 0, 0, 0, 0, 0};
            int Rp = 0;
            for (int j8 = 0; j8 < 16; ++j8) {
                const int Rb = b * LP + r0 + j8 * 8;
                float q1[8], q2[8], k1[8], k2[8]; f32x2 cs[8];
                if (j8 >= npad8) {
#pragma unroll
                    for (int jj = 0; jj < 8; ++jj) {
                        const size_t o_ = (size_t)(Rb + jj) * 1024;
                        q1[jj] = bf2f(qraw[o_ + c]); q2[jj] = bf2f(qraw[o_ + pc]); k1[jj] = bf2f(kraw[o_ + c]); k2[jj] = bf2f(kraw[o_ + pc]);
                        cs[jj] = ROPE[(r0 + j8 * 8 + jj - PADR) * 64 + (d & 63)];
                    }
                }
                if (j8 > 0) {
#pragma unroll
                    for (int jj = 0; jj < 8; ++jj) { qd[(size_t)(Rp + jj) * 1024 + c] = qo[jj]; kd[(size_t)(Rp + jj) * 1024 + c] = ko[jj]; }
                }
                unsigned kp[4] = {0u, 0u, 0u, 0u};
                if (j8 >= npad8) {
                    float kv[8];
#pragma unroll
                    for (int jj = 0; jj < 8; ++jj) {
                        const float qr = (d < 64) ? (q1[jj] * cs[jj].x - q2[jj] * cs[jj].y) : (q2[jj] * cs[jj].y + q1[jj] * cs[jj].x);
                        const float kr = ((d < 64) ? (k1[jj] * cs[jj].x - k2[jj] * cs[jj].y) : (k2[jj] * cs[jj].y + k1[jj] * cs[jj].x)) * 0.08838834764831845f;
                        const float bj = lg * (float)(j8 * 8 + jj + 1);
                        qo[jj] = f2bf(qr * __expf(bj));
                        kv[jj] = kr * __expf(-bj);
                        ko[jj] = f2bf(kv[jj]);
                    }
                    kp[0] = cvt_pk_bf16(kv[0], kv[1]); kp[1] = cvt_pk_bf16(kv[2], kv[3]); kp[2] = cvt_pk_bf16(kv[4], kv[5]); kp[3] = cvt_pk_bf16(kv[6], kv[7]);
                } else {
#pragma unroll
                    for (int jj = 0; jj < 8; ++jj) { qo[jj] = 0; ko[jj] = 0; }
                }
                Rp = Rb;
                *(LAS u32x4*)(tl + j8 * 16) = (u32x4){kp[0], kp[1], kp[2], kp[3]};
            }
#pragma unroll
            for (int jj = 0; jj < 8; ++jj) { qd[(size_t)(Rp + jj) * 1024 + c] = qo[jj]; kd[(size_t)(Rp + jj) * 1024 + c] = ko[jj]; }
        } else {
            const int h = c >> 8, d = c & 255;
            float wg[16];
#pragma unroll
            for (int r = 0; r < 16; ++r) wg[r] = C.w_gate[r * 1024 + c];
            const float bg = C.b_gate[c];
            LAS float* gl = (LAS float*)(lds + 139264);
            *(LAS f32x4*)(gl + (tid >> 2) * 16 + (tid & 3) * 4) = *(const f32x4*)(GLOW + (size_t)(b * LP + r0 + (tid >> 2)) * 16 + (tid & 3) * 4);
            __syncthreads();
            bf16_t qo[8] = {0, 0, 0, 0, 0, 0, 0, 0}, ko[8] = {0, 0, 0, 0, 0, 0, 0, 0};
            int Rp = 0;
            float bc = 0.f;
            for (int j8 = 0; j8 < 16; ++j8) {
                const int Rb = b * LP + r0 + j8 * 8;
                float qv[8], kr[8];
                if (j8 >= npad8) {
#pragma unroll
                    for (int jj = 0; jj < 8; ++jj) { const size_t o_ = (size_t)(Rb + jj) * 1024 + c; qv[jj] = bf2f(qraw[o_]); kr[jj] = bf2f(kraw[o_]); }
                }
                if (j8 > 0) {
#pragma unroll
                    for (int jj = 0; jj < 8; ++jj) { qd[(size_t)(Rp + jj) * 1024 + c] = qo[jj]; kd[(size_t)(Rp + jj) * 1024 + c] = ko[jj]; }
                }
                unsigned kp[4] = {0u, 0u, 0u, 0u};
                if (j8 >= npad8) {
                    float kv[8];
#pragma unroll
                    for (int jj = 0; jj < 8; ++jj) {
                        const LAS float* gr = gl + (j8 * 8 + jj) * 16;
                        const f32x4 g0 = *(const LAS f32x4*)(gr), g1 = *(const LAS f32x4*)(gr + 4), g2 = *(const LAS f32x4*)(gr + 8), g3 = *(const LAS f32x4*)(gr + 12);
                        float xg = bg;
                        xg += g0[0] * wg[0] + g0[1] * wg[1] + g0[2] * wg[2] + g0[3] * wg[3]; xg += g1[0] * wg[4] + g1[1] * wg[5] + g1[2] * wg[6] + g1[3] * wg[7];
                        xg += g2[0] * wg[8] + g2[1] * wg[9] + g2[2] * wg[10] + g2[3] * wg[11]; xg += g3[0] * wg[12] + g3[1] * wg[13] + g3[2] * wg[14] + g3[3] * wg[15];
                        const float la = (fminf(xg, 0.f) - __logf(1.f + __expf(-fabsf(xg)))) * 0.0625f;
                        bc += la;
                        qo[jj] = f2bf(qv[jj] * 0.0625f * __expf(bc));
                        kv[jj] = kr[jj] * __expf(-bc);
                        ko[jj] = f2bf(kv[jj]);
                    }
                    kp[0] = cvt_pk_bf16(kv[0], kv[1]); kp[1] = cvt_pk_bf16(kv[2], kv[3]); kp[2] = cvt_pk_bf16(kv[4], kv[5]); kp[3] = cvt_pk_bf16(kv[6], kv[7]);
                } else {
#pragma unroll
                    for (int jj = 0; jj < 8; ++jj) { qo[jj] = 0; ko[jj] = 0; }
                }
                Rp = Rb;
                *(LAS u32x4*)(tl + j8 * 16) = (u32x4){kp[0], kp[1], kp[2], kp[3]};
            }
#pragma unroll
            for (int jj = 0; jj < 8; ++jj) { qd[(size_t)(Rp + jj) * 1024 + c] = qo[jj]; kd[(size_t)(Rp + jj) * 1024 + c] = ko[jj]; }
            DEC1[((b * 4 + h) * NCH + n) * 256 + d] = __expf(bc);
        }
    } else {
        const int v = (part - 2) * 512 + tid;
        constexpr int DVp = LAYER == 0 ? 256 : 512;
        const bf16_t* vraw = LAYER == 0 ? V0RAW : V1RAW; bf16_t* vt = (LAYER == 0 ? VT0 : VT1) + ((size_t)(((b * 2048 + v) / DVp) * NCH + n) * DVp + (v % DVp)) * 128;
        for (int j8 = 0; j8 < 16; ++j8) {
            unsigned short e[8] = {0, 0, 0, 0, 0, 0, 0, 0};
            if (j8 >= npad8) {
                const bf16_t* vp = vraw + (size_t)(b * LP + r0 + j8 * 8) * 2048 + v;
#pragma unroll
                for (int jj = 0; jj < 8; ++jj) e[jj] = vp[jj * 2048];
            }
            u32x4 w; w.x = e[0] | ((unsigned)e[1] << 16); w.y = e[2] | ((unsigned)e[3] << 16); w.z = e[4] | ((unsigned)e[5] << 16); w.w = e[6] | ((unsigned)e[7] << 16);
            *(LAS u32x4*)(tl + j8 * 16) = w;
        }
    }
    __syncthreads();
#pragma unroll 4
    for (int i = 0; i < 16; ++i) {
        const int p_ = tid + i * 512, rr = p_ >> 4, c8 = p_ & 15;
        bf16_t* dst;
        if (part < 2) {
            const int c = part * 512 + rr;
            if (LAYER == 0) dst = KT0 + ((size_t)((b * 8 + (c >> 7)) * NCH + n) * 128 + (c & 127)) * 128;
            else dst = KT1 + ((size_t)((b * 4 + (c >> 8)) * NCH + n) * 256 + (c & 255)) * 128;
        } else {
            constexpr int DVq = LAYER == 0 ? 256 : 512;
            const int rowid = b * 2048 + (part - 2) * 512 + rr;
            dst = (LAYER == 0 ? VT0 : VT1) + ((size_t)((rowid / DVq) * NCH + n) * DVq + (rowid % DVq)) * 128;
        }
        *(u32x4*)(dst + c8 * 8) = *(const LAS u32x4*)(lds + (unsigned)rr * 272u + c8 * 16);
    }
    __syncthreads();
}

template <bool FULL>
__device__ __forceinline__ void s5_task(const Ctx& C, int task, int lane, LAS bf16_t* xs) {
    const int b = task / (64 * NCH), g = (task / NCH) % 64, n = task % NCH, p = lane, gp = g * 64 + p;
    const int fr = lane & 15, fq = lane >> 4;
    LAS float* xf = (LAS float*)(xs + 16 * 136);
    bf16x8 bbf[8];
#pragma unroll
    for (int blk = 0; blk < 8; ++blk) bbf[blk] = *(const bf16x8*)(S5BBT + (size_t)(g * 128 + blk * 16 + fr) * 32 + fq * 8);
    const f32x2 a = S5AB[gp];
    float xr = 0.f, xi = 0.f;
    bf16x8 cf[4];
    float dv = 0.f;
    if (FULL) {
        const f32x2 a128 = S5A128[gp];
        const float* e = S5E + (size_t)((b * 64 + g) * NCH) * 128;
        for (int m0 = 0; m0 < n; m0 += 8) {
            float er[8], ei[8];
#pragma unroll
            for (int k = 0; k < 8; ++k) { const int mm = (m0 + k < n) ? m0 + k : n - 1; er[k] = e[mm * 128 + p]; ei[k] = e[mm * 128 + 64 + p]; }
#pragma unroll
            for (int k = 0; k < 8; ++k) { const float nr = a128.x * xr - a128.y * xi + er[k], ni = a128.x * xi + a128.y * xr + ei[k]; const bool ok = (m0 + k < n); xr = ok ? nr : xr; xi = ok ? ni : xi; }
        }
#pragma unroll
        for (int kk = 0; kk < 4; ++kk) cf[kk] = *(const bf16x8*)(S5C + (g * 16 + fr) * 128 + kk * 32 + fq * 8);
        dv = C.s5d[g * 16 + fr];
    }
    const int j16s = (n == 0) ? 7 : 0;
    bf16x8 uf = {0, 0, 0, 0, 0, 0, 0, 0}, ufn = {0, 0, 0, 0, 0, 0, 0, 0};
    if (fq < 2) uf = *(const bf16x8*)(U0 + (size_t)(b * LP + n * 128 + j16s * 16 + fr) * 1024 + g * 16 + fq * 8);
    bf16_t ue[4] = {0, 0, 0, 0}, uen[4] = {0, 0, 0, 0};
    if (FULL) {
#pragma unroll
        for (int j = 0; j < 4; ++j) ue[j] = U0[(size_t)(b * LP + n * 128 + j16s * 16 + 4 * fq + j) * 1024 + g * 16 + fr];
    }
    for (int j16 = j16s; j16 < 8; ++j16) {
        const int Rb = b * LP + n * 128 + j16 * 16;
        if (fq < 2 && j16 < 7) ufn = *(const bf16x8*)(U0 + (size_t)(Rb + 16 + fr) * 1024 + g * 16 + fq * 8);
        if (FULL && j16 < 7) {
#pragma unroll
            for (int j = 0; j < 4; ++j) uen[j] = U0[(size_t)(Rb + 16 + 4 * fq + j) * 1024 + g * 16 + fr];
        }
#pragma unroll
        for (int blk = 0; blk < 8; ++blk) { const f32x4 d = mfma16(uf, bbf[blk], (f32x4){0.f, 0.f, 0.f, 0.f});
#pragma unroll
            for (int j = 0; j < 4; ++j) xf[(4 * fq + j) * 132 + blk * 16 + fr] = d[j]; }
        LDS_FENCE();
#pragma unroll
        for (int jj = 0; jj < 16; ++jj) {
            const float bur = xf[jj * 132 + p], bui = xf[jj * 132 + 64 + p];
            const float nr = a.x * xr - a.y * xi + bur, ni = a.x * xi + a.y * xr + bui; xr = nr; xi = ni;
            if (FULL) { xs[jj * 136 + p] = f2bf(xr); xs[jj * 136 + 64 + p] = f2bf(xi); }
        }
        LDS_FENCE();
        if (FULL) {
            f32x4 acc = {0.f, 0.f, 0.f, 0.f};
            bf16x8 af[4];
#pragma unroll
            for (int kk = 0; kk < 4; ++kk) af[kk] = *(const LAS bf16x8*)(xs + fr * 136 + kk * 32 + fq * 8);
            LDS_FENCE();
#pragma unroll
            for (int kk = 0; kk < 4; ++kk) acc = mfma16(af[kk], cf[kk], acc);
#pragma unroll
            for (int j = 0; j < 4; ++j) { const size_t o = (size_t)(Rb + 4 * fq + j) * 1024 + g * 16 + fr; const float y = acc[j] + dv * bf2f(ue[j]); YG[o] = f2bf(gelu_tanh(y)); }
        }
        uf = ufn;
#pragma unroll
        for (int j = 0; j < 4; ++j) ue[j] = uen[j];
    }
    if (!FULL) { float* e = S5E + (size_t)((b * 64 + g) * NCH + n) * 128; e[p] = xr; e[64 + p] = xi; }
}

template <int LAYER>
__device__ __forceinline__ void kvscan_task(const Ctx& C, int task, int lane) {
    constexpr int H = LAYER == 0 ? 8 : 4, DK = LAYER == 0 ? 128 : 256, DV = LAYER == 0 ? 256 : 512, NDB = DK / 64, NVB = DV / 16;
    const int db = task % NDB, vb = (task / NDB) % NVB, bh = task / (NDB * NVB), h = bh % H;
    const int fr = lane & 15, fq = lane >> 4, d0 = db * 64, v0 = vb * 16;
    const bf16_t* kt = (LAYER == 0 ? KT0 : KT1) + (size_t)(bh * DK + d0 + fr) * LP + fq * 8;
    const bf16_t* vt = (LAYER == 0 ? VT0 : VT1) + (size_t)(bh * DV + v0 + fr) * LP + fq * 8;
    bf16_t* sp = (LAYER == 0 ? SP0 : SP1) + (size_t)(bh * NCH) * DV * DK + (size_t)(v0 + fr) * DK + d0 + 4 * fq;
    const float g128 = (LAYER == 0) ? (float)exp(128.0 * log1p(-exp2(-5.0 - (double)h))) : 1.f;
    f32x4 acc[4];
#pragma unroll
    for (int i = 0; i < 4; ++i) acc[i] = (f32x4){0.f, 0.f, 0.f, 0.f};
    bf16x8 fa[4][4], fb[4];
#pragma unroll
    for (int kk = 0; kk < 4; ++kk) { fb[kk] = *(const bf16x8*)(vt + kk * 32);
#pragma unroll
        for (int blk = 0; blk < 4; ++blk) fa[blk][kk] = *(const bf16x8*)(kt + (size_t)(blk * 16) * LP + kk * 32); }
    for (int n = 0; n < NCH; ++n) {
#pragma unroll
        for (int blk = 0; blk < 4; ++blk) { u32x2 w; w.x = cvt_pk_bf16(acc[blk][0], acc[blk][1]); w.y = cvt_pk_bf16(acc[blk][2], acc[blk][3]); *(u32x2*)(sp + (size_t)n * DV * DK + blk * 16) = w; }
        if (n == NCH - 1) break;
        bf16x8 na[4][4], nb[4];
        const int nn = (n + 1 < NCH - 1) ? n + 1 : n;
#pragma unroll
        for (int kk = 0; kk < 4; ++kk) { nb[kk] = *(const bf16x8*)(vt + nn * 128 + kk * 32);
#pragma unroll
            for (int blk = 0; blk < 4; ++blk) na[blk][kk] = *(const bf16x8*)(kt + (size_t)(blk * 16) * LP + nn * 128 + kk * 32); }
#pragma unroll
        for (int kk = 0; kk < 4; ++kk)
#pragma unroll
            for (int blk = 0; blk < 4; ++blk) acc[blk] = mfma16(fa[blk][kk], fb[kk], acc[blk]);
        if (LAYER == 0) {
#pragma unroll
            for (int blk = 0; blk < 4; ++blk) acc[blk] = acc[blk] * g128;
        } else {
#pragma unroll
            for (int blk = 0; blk < 4; ++blk) { const f32x4 dc = *(const f32x4*)(DEC1 + (size_t)(bh * NCH + n) * DK + d0 + blk * 16 + 4 * fq); acc[blk] = acc[blk] * dc; }
        }
#pragma unroll
        for (int kk = 0; kk < 4; ++kk) { fb[kk] = nb[kk];
#pragma unroll
            for (int blk = 0; blk < 4; ++blk) fa[blk][kk] = na[blk][kk]; }
    }
}

template <int LAYER>
__device__ __forceinline__ void mixout_task(const Ctx& C, int task, int lane, LAS bf16_t* xs) {
    constexpr int H = LAYER == 0 ? 8 : 4, DK = LAYER == 0 ? 128 : 256, DV = LAYER == 0 ? 256 : 512, NKK = DK / 32, NVB = DV / 16;
    constexpr int TPB = LAYER == 0 ? 257 : 256;
    const int bh = task / TPB, rem = task % TPB, b = bh / H, h = bh % H;
    const int n = (rem == 256) ? 0 : 1 + (rem >> 3), rb = (rem == 256) ? 7 : (rem & 7);
    const int fr = lane & 15, fq = lane >> 4;
    const bf16_t* qd = LAYER == 0 ? QD0 : QD1; const bf16_t* kd = LAYER == 0 ? KD0 : KD1;
    const int Rc = b * LP + n * 128, R0 = Rc + rb * 16;
    bf16x8 qf[NKK];
#pragma unroll
    for (int kk = 0; kk < NKK; ++kk) qf[kk] = *(const bf16x8*)(qd + (size_t)(R0 + fr) * 1024 + h * DK + kk * 32 + fq * 8);
    for (int jb = 0; jb <= rb; ++jb) {
        f32x4 s = {0.f, 0.f, 0.f, 0.f};
        const bf16_t* kp = kd + (size_t)(Rc + jb * 16 + fr) * 1024 + h * DK + fq * 8;
#pragma unroll
        for (int kk = 0; kk < NKK; ++kk) s = mfma16(qf[kk], *(const bf16x8*)(kp + kk * 32), s);
#pragma unroll
        for (int j = 0; j < 4; ++j) { float v = s[j]; if (jb == rb && fr > 4 * fq + j) v = 0.f; xs[(4 * fq + j) * 136 + jb * 16 + fr] = f2bf(v); }
    }
    if ((rb & 1) == 0) {
#pragma unroll
        for (int j = 0; j < 4; ++j) xs[(4 * fq + j) * 136 + (rb + 1) * 16 + fr] = 0;
    }
    const int nks = (rb >> 1) + 1;
    bf16x8 sf[4];
    LDS_FENCE();
#pragma unroll
    for (int kk = 0; kk < 4; ++kk) sf[kk] = *(const LAS bf16x8*)(xs + fr * 136 + (kk < nks ? kk : 0) * 32 + fq * 8);
    LDS_FENCE();
    const bf16_t* vt = (LAYER == 0 ? VT0 : VT1) + (size_t)(bh * DV + fr) * LP + n * 128 + fq * 8;
    const bf16_t* sp = (LAYER == 0 ? SP0 : SP1) + (size_t)(bh * NCH + n) * DV * DK + (size_t)fr * DK + fq * 8;
    f32x4 acc[NVB];
    float ssq[4] = {0.f, 0.f, 0.f, 0.f};
#pragma unroll
    for (int vb = 0; vb < NVB; ++vb) {
        f32x4 o = {0.f, 0.f, 0.f, 0.f};
#pragma unroll
        for (int kk = 0; kk < 4; ++kk) if (kk < nks) o = mfma16(sf[kk], *(const bf16x8*)(vt + (size_t)(vb * 16) * LP + kk * 32), o);
#pragma unroll
        for (int kk = 0; kk < NKK; ++kk) if (DBG_INTER) o = mfma16(qf[kk], *(const bf16x8*)(sp + (size_t)(vb * 16) * DK + kk * 32), o);
        acc[vb] = o;
#pragma unroll
        for (int j = 0; j < 4; ++j) ssq[j] += o[j] * o[j];
    }
    float rstd[4];
#pragma unroll
    for (int j = 0; j < 4; ++j) { float s = ssq[j]; s += __shfl_xor(s, 1); s += __shfl_xor(s, 2); s += __shfl_xor(s, 4); s += __shfl_xor(s, 8); rstd[j] = rsqrtf(s * (1.f / DV) + EPS); }
    const float* nw = (LAYER == 0 ? C.ret_norm_w : C.gla_norm_w) + h * DV + fr;
    const bf16_t* zp = (LAYER == 0 ? ZA0 : Z1) + h * DV + fr;
    bf16_t* yp = (LAYER == 0 ? YCAT : Y1) + h * DV + fr;
    constexpr int YLD = LAYER == 0 ? 3072 : 2048;
#pragma unroll
    for (int vb = 0; vb < NVB; ++vb) {
        const float w = nw[vb * 16];
#pragma unroll
        for (int j = 0; j < 4; ++j) { const int R = R0 + 4 * fq + j; const float z = bf2f(zp[(size_t)R * 2048 + vb * 16]); yp[(size_t)R * YLD + vb * 16] = DBG_NORM ? f2bf(acc[vb][j] * rstd[j] * w * siluf_(z)) : f2bf(acc[vb][j]); }
    }
}


__device__ __forceinline__ int block_fetch(unsigned* ctr, LAS int* slot, int tid) { __syncthreads(); if (tid == 0) *slot = (int)atomicAdd(ctr, 1u); __syncthreads(); return (int)__builtin_amdgcn_readfirstlane((unsigned)*slot); }
template <int LAYER>
__device__ __forceinline__ void kvscan_wg(const Ctx& C, int task, LAS unsigned char* lds, int tid, int lane, int wave) {
    constexpr int H = LAYER == 0 ? 8 : 4, DK = LAYER == 0 ? 128 : 256, DV = LAYER == 0 ? 256 : 512, NVG = DV / 32, NB = DK / 64, TP = 136, TILEB = DK * TP * 2, NPC = DK / 32;
    constexpr int VTO = 2 * TILEB + 2048, VTB = 32 * TP * 2;
    const int bh = task / NVG, vg = task % NVG, h = bh % H, vb = wave & 1, dh = wave >> 1, fr = lane & 15, fq = lane >> 4;
    const bf16_t* ktg = (LAYER == 0 ? KT0 : KT1) + (size_t)(bh * NCH) * DK * 128;
    const bf16_t* vtg = (LAYER == 0 ? VT0 : VT1) + (size_t)(bh * NCH) * DV * 128 + (size_t)(vg * 32) * 128;
    bf16_t* sp = (LAYER == 0 ? SP0 : SP1) + (size_t)(bh * NCH) * DV * DK + (size_t)(vg * 32 + vb * 16 + fr) * DK + dh * (DK / 4) + 4 * fq;
    const float g128 = (LAYER == 0) ? (float)exp(128.0 * log1p(-exp2(-5.0 - (double)h))) : 1.f;
    LAS float* decl = (LAS float*)(lds + 2 * TILEB);
    f32x4 acc[NB];
#pragma unroll
    for (int i = 0; i < NB; ++i) acc[i] = (f32x4){0.f, 0.f, 0.f, 0.f};
    u32x4 r0[NPC], r1[NPC], v0, v1; f32x4 d0 = {1.f, 1.f, 1.f, 1.f}, d1 = {1.f, 1.f, 1.f, 1.f};
    const unsigned kvo = (unsigned)((tid >> 4) * 128 + (tid & 15) * 8) * 2u;
    const unsigned lwo = (unsigned)((tid >> 4) * TP + (tid & 15) * 8) * 2u;
    constexpr int RB = DK / 2, VPT = 256 / RB, PPR = RB / 16, NST = 16 * PPR / 64;
    const unsigned spw = (unsigned)(((4 * wave + ((fr / VPT) & 3) + 32 * ((fr / VPT) >> 2)) * TP) * 2 + (fr % VPT) * RB + fq * 8);
    unsigned spr[NST]; bf16_t* spg[NST];
#pragma unroll
    for (int s_ = 0; s_ < NST; ++s_) { const int P_ = lane + 64 * s_, v_ = P_ / PPR, c_ = P_ % PPR, k_ = v_ / VPT;
        spr[s_] = (unsigned)(((4 * wave + (k_ & 3) + 32 * (k_ >> 2)) * TP) * 2 + (v_ % VPT) * RB + c_ * 16);
        spg[s_] = (LAYER == 0 ? SP0 : SP1) + (size_t)(bh * NCH) * DV * DK + (size_t)(vg * 32 + vb * 16 + v_) * DK + dh * (DK / 4) + c_ * 8; }
#define KV_SPSTORE(n_, fb_) do { \
        _Pragma("unroll") for (int blk = 0; blk < NB; ++blk) { u32x2 w; w.x = cvt_pk_bf16(acc[blk][0], acc[blk][1]); w.y = cvt_pk_bf16(acc[blk][2], acc[blk][3]); *(LAS u32x2*)(lds + (fb_) * TILEB + spw + blk * 32) = w; } \
        LDS_FENCE(); \
        { u32x4 t_[NST]; _Pragma("unroll") for (int s_ = 0; s_ < NST; ++s_) t_[s_] = *(const LAS u32x4*)(lds + (fb_) * TILEB + spr[s_]); \
          LDS_FENCE(); \
          _Pragma("unroll") for (int s_ = 0; s_ < NST; ++s_) *(u32x4*)(spg[s_] + (size_t)(n_) * DV * DK) = t_[s_]; } } while (0)
#define KV_LOAD(R, D, V, nn) do { _Pragma("unroll") for (int i = 0; i < NPC; ++i) { R[i] = *(const u32x4*)((const char*)(ktg + (size_t)(nn) * DK * 128 + (i * 32) * 128) + kvo); } \
        V = *(const u32x4*)((const char*)(vtg + (size_t)(nn) * DV * 128) + kvo); \
        if (LAYER == 1 && tid < DK / 4) D = *(const f32x4*)(DEC1 + (size_t)(bh * NCH + (nn)) * DK + tid * 4); } while (0)
#define KV_WRITE(R, D, V, bb) do { _Pragma("unroll") for (int i = 0; i < NPC; ++i) { *(LAS u32x4*)(lds + (bb) * TILEB + i * 32 * TP * 2 + lwo) = R[i]; } \
        *(LAS u32x4*)(lds + VTO + (bb) * VTB + lwo) = V; \
        if (LAYER == 1 && tid < DK / 4) *(LAS f32x4*)(decl + (bb) * DK + tid * 4) = D; } while (0)
#define KV_STEP(n_, RW, DW, VW) do { \
        KV_SPSTORE(n_, ((n_) + 1) & 1); \
        KV_WRITE(RW, DW, VW, ((n_) + 1) & 1); \
        KV_LOAD(RW, DW, VW, ((n_) + 3 < 32 ? (n_) + 3 : 31)); \
        { const LAS unsigned char* tb = lds + ((n_) & 1) * TILEB + ((dh * (DK / 4) + fr) * TP + fq * 8) * 2; \
          const LAS unsigned char* vbp = lds + VTO + ((n_) & 1) * VTB + ((vb * 16 + fr) * TP + fq * 8) * 2; \
          _Pragma("unroll") for (int kk = 0; kk < 4; ++kk) { bf16x8 af[NB]; const bf16x8 bfv = *(const LAS bf16x8*)(vbp + kk * 64); \
            _Pragma("unroll") for (int blk = 0; blk < NB; ++blk) af[blk] = *(const LAS bf16x8*)(tb + (blk * 16 * TP + kk * 32) * 2); \
            _Pragma("unroll") for (int blk = 0; blk < NB; ++blk) acc[blk] = mfma16(af[blk], bfv, acc[blk]); } } \
        if (LAYER == 0) { _Pragma("unroll") for (int blk = 0; blk < NB; ++blk) acc[blk] = acc[blk] * g128; } \
        else { _Pragma("unroll") for (int blk = 0; blk < NB; ++blk) { const f32x4 dc = *(const LAS f32x4*)(decl + ((n_) & 1) * DK + dh * (DK / 4) + blk * 16 + 4 * fq); acc[blk] = acc[blk] * dc; } } \
        LBAR(); } while (0)
    KV_LOAD(r0, d0, v0, 0); KV_WRITE(r0, d0, v0, 0); KV_LOAD(r1, d1, v1, 1); KV_LOAD(r0, d0, v0, 2);
    LBAR();
    for (int nb = 0; nb < 32; nb += 2) {
        KV_STEP(nb + 0, r1, d1, v1);
        KV_STEP(nb + 1, r0, d0, v0);
    }
    KV_SPSTORE(32, 1);
#undef KV_LOAD
#undef KV_WRITE
#undef KV_STEP
#undef KV_SPSTORE
    LBAR();
}

template <int LAYER>
__device__ __forceinline__ void mixout_wg(const Ctx& C, int task, LAS unsigned char* lds, int tid, int lane, int wave) {
    constexpr int H = LAYER == 0 ? 8 : 4, DK = LAYER == 0 ? 128 : 256, DV = LAYER == 0 ? 256 : 512, NKK = DK / 32, NSLAB = DV / 64, KP = DK + 8;
    constexpr int NSP = DK / 64, XSB = 8 * 4352, SPB = 64 * KP * 2, SLABB = SPB + 64 * 136 * 2, YLD = LAYER == 0 ? 3072 : 2048;
    const int bh = (LAYER == 0) ? task / NCH : task / 32, n = (LAYER == 0) ? task % NCH : 1 + task % 32, b = bh / H, h = bh % H, rb = wave;
    const int fr = lane & 15, fq = lane >> 4;
    const bf16_t* qd = LAYER == 0 ? QD0 : QD1; const bf16_t* kd = LAYER == 0 ? KD0 : KD1;
    const int Rc = b * LP + n * 128, R0 = Rc + rb * 16;
    LAS bf16_t* xs = (LAS bf16_t*)(lds + wave * 4352);
    const bf16_t* spg = (LAYER == 0 ? SP0 : SP1) + (size_t)(bh * NCH + n) * DV * DK;
    const bf16_t* vtg = (LAYER == 0 ? VT0 : VT1) + (size_t)(bh * NCH + n) * DV * 128;
    u32x4 rs[NSP], rv[2];
    const unsigned spo = (unsigned)((tid / (DK / 8)) * DK + (tid % (DK / 8)) * 8) * 2u, vto = (unsigned)((tid >> 4) * 128 + (tid & 15) * 8) * 2u;
#define MX_LOAD(s_) do { _Pragma("unroll") for (int i = 0; i < NSP; ++i) { rs[i] = *(const u32x4*)((const char*)(spg + (size_t)((s_) * 64 + i * (4096 / DK)) * DK) + spo); } \
        _Pragma("unroll") for (int i = 0; i < 2; ++i) { rv[i] = *(const u32x4*)((const char*)(vtg + (size_t)((s_) * 64 + i * 32) * 128) + vto); } } while (0)
#define MX_WRITE(bb) do { _Pragma("unroll") for (int i = 0; i < NSP; ++i) { const int p_ = tid + i * 512, row_ = p_ / (DK / 8), c8_ = p_ % (DK / 8); *(LAS u32x4*)(lds + XSB + (bb) * SLABB + (row_ * KP + c8_ * 8) * 2) = rs[i]; } \
        _Pragma("unroll") for (int i = 0; i < 2; ++i) { const int p_ = tid + i * 512, row_ = p_ >> 4, c8_ = p_ & 15; *(LAS u32x4*)(lds + XSB + (bb) * SLABB + SPB + (row_ * 136 + c8_ * 8) * 2) = rv[i]; } } while (0)
    bf16x8 qf[NKK];
#pragma unroll
    for (int kk = 0; kk < NKK; ++kk) qf[kk] = *(const bf16x8*)(qd + (size_t)(R0 + fr) * 1024 + h * DK + kk * 32 + fq * 8);
    {
        constexpr int NKP = DK / 32;
        u32x4 rk[NKP];
        const unsigned ko = (unsigned)((tid / (DK / 8)) * 1024 + (tid % (DK / 8)) * 8) * 2u;
#pragma unroll
        for (int i = 0; i < NKP; ++i) rk[i] = *(const u32x4*)((const char*)(kd + (size_t)(Rc + i * (4096 / DK)) * 1024 + h * DK) + ko);
#pragma unroll
        for (int i = 0; i < NKP; ++i) { const int p_ = tid + i * 512, row_ = p_ / (DK / 8), c8_ = p_ % (DK / 8); *(LAS u32x4*)(lds + XSB + (row_ * KP + c8_ * 8) * 2) = rk[i]; }
        LBAR();
    }
    MX_LOAD(0);
    for (int jb = 0; jb <= rb; ++jb) {
        f32x4 s = {0.f, 0.f, 0.f, 0.f};
        const LAS unsigned char* kp = lds + XSB + ((jb * 16 + fr) * KP + fq * 8) * 2;
#pragma unroll
        for (int kk = 0; kk < NKK; ++kk) s = mfma16(qf[kk], *(const LAS bf16x8*)(kp + kk * 64), s);
#pragma unroll
        for (int j = 0; j < 4; ++j) { float v = s[j]; if (jb == rb && fr > 4 * fq + j) v = 0.f; xs[(4 * fq + j) * 136 + jb * 16 + fr] = f2bf(v); }
    }
    if ((rb & 1) == 0) {
#pragma unroll
        for (int j = 0; j < 4; ++j) xs[(4 * fq + j) * 136 + (rb + 1) * 16 + fr] = 0;
    }
    const int nks = (rb >> 1) + 1;
    LBAR();
    MX_WRITE(0); MX_LOAD(1);
    LBAR();
    f32x4 acc[NSLAB * 4];
    float ssq[4] = {0.f, 0.f, 0.f, 0.f};
#pragma unroll
    for (int s_ = 0; s_ < NSLAB; ++s_) {
        const LAS unsigned char* sb = lds + XSB + (s_ & 1) * SLABB;
#pragma unroll
        for (int vb = 0; vb < 4; ++vb) {
            f32x4 o = {0.f, 0.f, 0.f, 0.f};
#pragma unroll
            for (int kk = 0; kk < 4; ++kk) if (kk < nks) o = mfma16(*(const LAS bf16x8*)(xs + fr * 136 + kk * 32 + fq * 8), *(const LAS bf16x8*)(sb + SPB + ((vb * 16 + fr) * 136 + kk * 32 + fq * 8) * 2), o);
#pragma unroll
            for (int k4 = 0; k4 < NKK; k4 += 4) { bf16x8 pf[4];
#pragma unroll
                for (int kk = 0; kk < 4; ++kk) pf[kk] = *(const LAS bf16x8*)(sb + ((vb * 16 + fr) * KP + (k4 + kk) * 32 + fq * 8) * 2);
#pragma unroll
                for (int kk = 0; kk < 4; ++kk) o = mfma16(qf[k4 + kk], pf[kk], o); }
            acc[s_ * 4 + vb] = o;
#pragma unroll
            for (int j = 0; j < 4; ++j) ssq[j] += o[j] * o[j];
        }
        if (s_ + 1 < NSLAB) { MX_WRITE((s_ + 1) & 1); if (s_ + 2 < NSLAB) MX_LOAD(s_ + 2); }
        LBAR();
    }
#undef MX_LOAD
#undef MX_WRITE
    float rstd[4];
#pragma unroll
    for (int j = 0; j < 4; ++j) { float s = ssq[j]; s += __shfl_xor(s, 1); s += __shfl_xor(s, 2); s += __shfl_xor(s, 4); s += __shfl_xor(s, 8); rstd[j] = rsqrtf(s * (1.f / DV) + EPS); }
    constexpr int ZP = DV + 8, NRW = DV / 512 > 0 ? DV / 512 : 1;
    LAS bf16_t* zt = (LAS bf16_t*)(lds + wave * 17408);
    const bf16_t* zg = (LAYER == 0 ? ZA0 : Z1) + (size_t)R0 * 2048 + h * DV;
    if (DV == 512) {
#pragma unroll
        for (int i = 0; i < 16; ++i) *(LAS u32x4*)(zt + i * ZP + lane * 8) = *(const u32x4*)(zg + (size_t)i * 2048 + lane * 8);
    } else {
#pragma unroll
        for (int i = 0; i < 8; ++i) { const int row = 2 * i + (lane >> 5), c8 = lane & 31; *(LAS u32x4*)(zt + row * ZP + c8 * 8) = *(const u32x4*)(zg + (size_t)row * 2048 + c8 * 8); }
    }
    LDS_FENCE();
    const float* nw = (LAYER == 0 ? C.ret_norm_w : C.gla_norm_w) + h * DV + fr;
#pragma unroll
    for (int vb = 0; vb < NSLAB * 4; ++vb) {
        const float w = nw[vb * 16];
#pragma unroll
        for (int j = 0; j < 4; ++j) { LAS bf16_t* e = zt + (4 * fq + j) * ZP + vb * 16 + fr; const float z = bf2f(*e); *e = f2bf(acc[vb][j] * rstd[j] * w * siluf_(z)); }
    }
    LDS_FENCE();
    bf16_t* yg = (LAYER == 0 ? YCAT : Y1) + (size_t)R0 * YLD + h * DV;
    if (DV == 512) {
#pragma unroll
        for (int i = 0; i < 16; ++i) *(u32x4*)(yg + (size_t)i * YLD + lane * 8) = *(const LAS u32x4*)(zt + i * ZP + lane * 8);
    } else {
#pragma unroll
        for (int i = 0; i < 8; ++i) { const int row = 2 * i + (lane >> 5), c8 = lane & 31; *(u32x4*)(yg + (size_t)row * YLD + c8 * 8) = *(const LAS u32x4*)(zt + row * ZP + c8 * 8); }
    }
    LBAR();
}

__device__ __forceinline__ void phase1(const Ctx& C, LAS unsigned char* lds, int tid, int lane, int wave, int bid, int G, int rep) {
    const int gw = wave * G + bid, NGW = G * 8; LAS bf16_t* xs = (LAS bf16_t*)(lds + wave * 16384); LAS int* slot = (LAS int*)(lds + 163776); (void)gw; (void)NGW; (void)xs; (void)slot;
        pg8::Gemm g{A0, W1T, 2048, 2048, 2048}; pg8::StaticOrder S; S.init(8192, 8192, G, bid);
        pg8::EpiProj<0> E{C};
        pg8::gemm_phase(lds, g, S, E);
        for (int t = bid; t < 512; t += G) {
            const f32x4 acc = skinny16_wg(A0 + (size_t)PADR * 2048, 2048, W1T + (size_t)t * 16 * 2048, 2048, 2048, lds, wave, lane);
            if (wave != 0) continue;
            bf16_t* dst; int ld, cc; pg8::route(C, 0, t * 16, dst, ld, cc);
#pragma unroll
            for (int j = 0; j < 4; ++j) { const int R = PADR + 4 * (lane >> 4) + j; const bf16_t v = f2bf(acc[j]); dst[(size_t)R * ld + cc + (lane & 15)] = v; dst[(size_t)(R + LP) * ld + cc + (lane & 15)] = v; }
        }
}

__device__ __forceinline__ void phase2(const Ctx& C, LAS unsigned char* lds, int tid, int lane, int wave, int bid, int G, int rep) {
    const int gw = wave * G + bid, NGW = G * 8; LAS bf16_t* xs = (LAS bf16_t*)(lds + wave * 16384); LAS int* slot = (LAS int*)(lds + 163776); (void)gw; (void)NGW; (void)xs; (void)slot;
        for (;;) { __syncthreads(); if (tid == 0) *slot = (int)atomicAdd(CTR + 0 + 8 * rep, 1u); __syncthreads(); const int it = *slot; if (it >= 2 * NCH * 6) break; prep_item<0>(C, it, tid, lds); }
        for (;;) { const int tb = wave_fetch_n(CTR + 1 + 8 * rep, 2u, lane); if (tb >= 2 * 64 * NCH) break; for (int t = tb; t < tb + 2 && t < 2 * 64 * NCH; ++t) s5_task<false>(C, t, lane, xs); }
}

__device__ __forceinline__ void phase3(const Ctx& C, LAS unsigned char* lds, int tid, int lane, int wave, int bid, int G, int rep) {
    const int gw = wave * G + bid, NGW = G * 8; LAS bf16_t* xs = (LAS bf16_t*)(lds + wave * 16384); LAS int* slot = (LAS int*)(lds + 163776); (void)gw; (void)NGW; (void)xs; (void)slot;
        constexpr int NK = 512, NS = 2 * 64 * NCH, NW3 = 32 * 193;
        for (;;) { const int t = block_fetch(CTR + 7 + 8 * rep, slot, tid); if (t >= 128) break; kvscan_wg<0>(C, t, lds, tid, lane, wave); }
        for (;;) { const int tb = wave_fetch_n(CTR + 2 + 8 * rep, 2u, lane); if (tb >= NS) break;
            for (int t = tb; t < tb + 2 && t < NS; ++t) s5_task<true>(C, t, lane, xs); }
        for (;;) { const int tb = wave_fetch_n(CTR + 16 + 8 * rep, 3u, lane); if (tb >= NW3) break;
            for (int t = tb; t < tb + 3 && t < NW3; ++t) transpose_item(C.w_in_c, 2048, 6160, W3T, (LAS float*)xs, t, lane); }
}

__device__ __forceinline__ void phase4(const Ctx& C, LAS unsigned char* lds, int tid, int lane, int wave, int bid, int G, int rep) {
    const int gw = wave * G + bid, NGW = G * 8; LAS bf16_t* xs = (LAS bf16_t*)(lds + wave * 16384); LAS int* slot = (LAS int*)(lds + 163776); (void)gw; (void)NGW; (void)xs; (void)slot;
        pg8::Gemm g{YG, WGLUT, 1024, 1024, 1024}; pg8::SubOrder S{4, bid, 128};
        pg8::EpiGLU E{C};
        pg8::gemm_phase(lds, g, S, E);
        for (int t = bid; t < 64; t += G) {
            {
                const f32x4 acc = skinny16_wg(YG + (size_t)PADR * 1024, 1024, WGLUT + (size_t)t * 16 * 1024, 1024, 1024, lds, wave, lane);
                if (wave != 0) continue;
#pragma unroll
                for (int j = 0; j < 4; ++j) { const int R = PADR + 4 * (lane >> 4) + j, col = t * 16 + (lane & 15);
                    const float y = bf2f(YG[(size_t)R * 1024 + col]), z = bf2f(ZB0[(size_t)R * 1024 + col]); const bf16_t o = f2bf(y * sigmoidf_(acc[j]) * siluf_(z));
                    YCAT[(size_t)R * 3072 + 2048 + col] = o; YCAT[(size_t)(R + LP) * 3072 + 2048 + col] = o; }
            }
        }
        for (;;) { const int t = block_fetch(CTR + 3 + 8 * rep, slot, tid); if (t >= 16 * NCH) break; mixout_wg<0>(C, t, lds, tid, lane, wave); }
}

__device__ __forceinline__ void phase6(const Ctx& C, LAS unsigned char* lds, int tid, int lane, int wave, int bid, int G, int rep) {
    const int gw = wave * G + bid, NGW = G * 8; LAS bf16_t* xs = (LAS bf16_t*)(lds + wave * 16384); LAS int* slot = (LAS int*)(lds + 163776); (void)gw; (void)NGW; (void)xs; (void)slot;
        pg8::Gemm g{A1, W3T, 2048, 2048, 2048}; pg8::StaticOrder S; S.init(8192, 6144, G, bid);
        pg8::EpiProj<1> E{C};
        pg8::gemm_phase(lds, g, S, E);
        for (int t = bid; t < 514 + 192; t += G) {
            if (t < 514) {
                const int b = t / 257, Rb = b * LP + PADR + (t % 257) * 16;
                const f32x4 acc = skinny16_wg(A1 + (size_t)Rb * 2048, 2048, W3T + (size_t)6144 * 2048, 2048, 2048, lds, wave, lane);
                if (wave != 0) continue;
#pragma unroll
                for (int j = 0; j < 4; ++j) { const int R = Rb + 4 * (lane >> 4) + j; GLOW[(size_t)R * 16 + (lane & 15)] = acc[j] * rsqrtf(SSQ1[R] * (1.f / 2048.f) + EPS); }
            } else {
                const int c3 = 1024 + (t - 514) * 16;
                const f32x4 acc = skinny16_wg(A1 + (size_t)PADR * 2048, 2048, W3T + (size_t)c3 * 2048, 2048, 2048, lds, wave, lane);
                if (wave != 0) continue;
                bf16_t* dst; int ld, cc; pg8::route(C, 1, c3, dst, ld, cc);
#pragma unroll
                for (int j = 0; j < 4; ++j) { const int R = PADR + 4 * (lane >> 4) + j; const bf16_t v = f2bf(acc[j] * rsqrtf(SSQ1[R] * (1.f / 2048.f) + EPS));
                    dst[(size_t)R * ld + cc + (lane & 15)] = v; dst[(size_t)(R + LP) * ld + cc + (lane & 15)] = v; }
            }
        }
}

__device__ __forceinline__ void phase7(const Ctx& C, LAS unsigned char* lds, int tid, int lane, int wave, int bid, int G, int rep) {
    const int gw = wave * G + bid, NGW = G * 8; LAS bf16_t* xs = (LAS bf16_t*)(lds + wave * 16384); LAS int* slot = (LAS int*)(lds + 163776); (void)gw; (void)NGW; (void)xs; (void)slot;
        for (;;) { __syncthreads(); if (tid == 0) *slot = (int)atomicAdd(CTR + 4 + 8 * rep, 1u); __syncthreads(); const int it = *slot; if (it >= 2 * NCH * 6) break; prep_item<1>(C, it, tid, lds); }
}

#define XB_TMO      128
#define XB_XCNT(j)  (256  + 64 * (j))
#define XB_XSUB(j)  (1280 + 64 * (j))
#define XB_XGEN(j)  (2304 + 64 * (j))
#define XB_TOP      3328
#define XB_TOPGEN   3392
#define XCD_BAR_WORDS 3456
#define XB_SPIN_CAP (1u << 22)
constexpr size_t M_BAR = 7340032;
__device__ __forceinline__ unsigned xb_ld(unsigned* p)              { return __hip_atomic_load(p, __ATOMIC_RELAXED, __HIP_MEMORY_SCOPE_AGENT); }
__device__ __forceinline__ unsigned xb_add(unsigned* p, unsigned v) { return __hip_atomic_fetch_add(p, v, __ATOMIC_RELAXED, __HIP_MEMORY_SCOPE_AGENT); }
__device__ __forceinline__ unsigned xb_xcc_id() { return (unsigned)__builtin_amdgcn_s_getreg((3 << 11) | 20) & 0xFu; }
#define XB_SPIN(cond, bar) do { unsigned _sp = 0; while (cond) { __builtin_amdgcn_s_sleep(1); \
    if ((++_sp & 255u) == 0u) { if (xb_ld(&(bar)[XB_TMO])) break; if (_sp > XB_SPIN_CAP) { atomicAdd(&(bar)[XB_TMO], 1u); break; } } } } while (0)
struct XcdBarrier { unsigned* bar; unsigned x; volatile LAS unsigned* st; };
__device__ __forceinline__ XcdBarrier xcd_barrier_post(unsigned* bar, volatile LAS unsigned* st) {
    XcdBarrier b; b.bar = bar; b.x = xb_xcc_id(); b.st = st;
    if (threadIdx.x == 0) (void)xb_add(&bar[XB_XCNT(b.x)], 1u);
    return b;
}
__device__ __forceinline__ void xcd_barrier_complete(unsigned* bar, unsigned x, unsigned& nloc, unsigned& nx) {
    const unsigned G = gridDim.x * gridDim.y * gridDim.z;
    unsigned sum, cnt, mine, sp = 0u;
    for (;;) {
        sum = 0u; cnt = 0u; mine = 0u;
#pragma unroll
        for (unsigned j = 0; j < 16; ++j) { const unsigned c = xb_ld(&bar[XB_XCNT(j)]); sum += c; cnt += (c > 0u) ? 1u : 0u; mine = (j == x) ? c : mine; }
        if (sum == G) break;
        __builtin_amdgcn_s_sleep(1);
        if ((++sp & 255u) == 0u) { if (xb_ld(&bar[XB_TMO])) break; if (sp > XB_SPIN_CAP) { atomicAdd(&bar[XB_TMO], 1u); break; } }
    }
    nloc = mine > 0u ? mine : 1u; nx = cnt > 0u ? cnt : 1u;
}
__device__ __forceinline__ void xcd_barrier(const XcdBarrier& b) {
    asm volatile("s_waitcnt vmcnt(0)" ::: "memory");
    __syncthreads();
    if (threadIdx.x == 0) {
        unsigned* bar = b.bar;
        __builtin_amdgcn_s_waitcnt(0);
        unsigned nloc = b.st[0], nx = b.st[1];
        if (nloc == 0u) { xcd_barrier_complete(bar, b.x, nloc, nx); b.st[0] = nloc; b.st[1] = nx; }
        const unsigned old = xb_add(&bar[XB_XSUB(b.x)], 1u);
        const unsigned gen = old / nloc;
        if (old + 1u == (gen + 1u) * nloc) {
            __builtin_amdgcn_fence(__ATOMIC_RELEASE, "agent");
            asm volatile("s_waitcnt vmcnt(0)" ::: "memory");
            const unsigned og = xb_add(&bar[XB_TOP], 1u);
            const unsigned tg = og / nx;
            if (og + 1u == (tg + 1u) * nx) xb_add(&bar[XB_TOPGEN], 1u);
            else XB_SPIN(xb_ld(&bar[XB_TOPGEN]) == tg, bar);
            __builtin_amdgcn_fence(__ATOMIC_ACQUIRE, "agent");
            xb_add(&bar[XB_XGEN(b.x)], 1u);
            asm volatile("s_waitcnt vmcnt(0)" ::: "memory");
        } else {
            XB_SPIN(xb_ld(&bar[XB_XGEN(b.x)]) == gen, bar);
            __builtin_amdgcn_fence(__ATOMIC_ACQUIRE, "agent");
            asm volatile("s_waitcnt vmcnt(0)" ::: "memory");
        }
    }
    __syncthreads();
}

__global__ void __launch_bounds__(512, 2) fwd(Ctx C) {
    extern __shared__ __attribute__((aligned(16))) unsigned char lds_raw[];
    LAS unsigned char* lds = (LAS unsigned char*)lds_raw;
    cg::grid_group grid = cg::this_grid();
    const int tid = threadIdx.x, lane = tid & 63, wave = __builtin_amdgcn_readfirstlane(tid >> 6), bid = blockIdx.x, G = gridDim.x;
    const int gw = wave * G + bid, NGW = G * 8;
    LAS bf16_t* xs = (LAS bf16_t*)(lds + wave * 16384);
    LAS int* slot = (LAS int*)(lds + 163776);
    const int lo = C.ph_lo, hi = C.ph_hi;
#define IN(k) (lo <= (k) && (k) < hi)
#define REPK(k) ((REP_MASK >> (k)) & 1)
#define REPLOOP(k) for (int rep = 0; rep <= REPK(k); ++rep)
#define REPSYNC(k) do { if (rep < REPK(k)) grid.sync(); } while (0)
#ifdef PROBE_A
    unsigned long long* STAMP = (unsigned long long*)WSB(MISC + 7000000);
#define STAMPIT(k) do { if (bid == 0 && tid == 0) STAMP[k] = __builtin_amdgcn_s_memrealtime(); } while (0)
#else
#define STAMPIT(k) do {} while (0)
#endif
    volatile LAS unsigned* bst = (volatile LAS unsigned*)(lds + 163792);
    if (tid < 2) bst[tid] = 0u;
    __syncthreads();
    XcdBarrier xbar = xcd_barrier_post((unsigned*)WSB(MISC + M_BAR), bst);
    if (C.ph_hi > 1000) grid.sync();
#define SEAM(k) do { if (IN(k) && IN((k) + 1)) xcd_barrier(xbar); STAMPIT((k) + 1); } while (0)
    STAMPIT(0);

    if (IN(0)) { p0_phase(C, lds, tid, lane, wave, bid, G); if (REPK(0)) { xcd_barrier(xbar); p0_phase(C, lds, tid, lane, wave, bid, G); } }
    SEAM(0);
    if (IN(1)) { phase1(C, lds, tid, lane, wave, bid, G, 0); if (REPK(1)) { xcd_barrier(xbar); phase1(C, lds, tid, lane, wave, bid, G, 1); } }
    SEAM(1);
    if (IN(2)) { phase2(C, lds, tid, lane, wave, bid, G, 0); if (REPK(2)) { xcd_barrier(xbar); phase2(C, lds, tid, lane, wave, bid, G, 1); } }
    SEAM(2);
    if (IN(3)) { phase3(C, lds, tid, lane, wave, bid, G, 0); if (REPK(3)) { xcd_barrier(xbar); phase3(C, lds, tid, lane, wave, bid, G, 1); } }
    SEAM(3);
    if (IN(4)) { phase4(C, lds, tid, lane, wave, bid, G, 0); if (REPK(4)) { xcd_barrier(xbar); phase4(C, lds, tid, lane, wave, bid, G, 1); } }
    SEAM(4);
    if (IN(5)) {
        pg8::Gemm g{YCAT, WO1T, 3072, 3072, 3072}; pg8::StaticOrder S; S.init(8192, 2048, G, bid);
        pg8::EpiOut<0> E{C};
        pg8::gemm_phase(lds, g, S, E);
        for (int t = bid; t < 128; t += G) {
            const f32x4 acc = skinny16_wg(YCAT + (size_t)PADR * 3072, 3072, WO1T + (size_t)t * 16 * 3072, 3072, 3072, lds, wave, lane);
            if (wave != 0) continue;
            const int col = t * 16 + (lane & 15); const float w = C.norm_c_w[col];
#pragma unroll
            for (int j = 0; j < 4; ++j) { const int mr = 4 * (lane >> 4) + j; const float hv = C.meta[(size_t)mr * DM + col] + acc[j];
                const bf16_t o = f2bf(hv * w); A1[(size_t)(PADR + mr) * DM + col] = o; A1[(size_t)(LP + PADR + mr) * DM + col] = o;
                float s = hv * hv; s += __shfl_xor(s, 1); s += __shfl_xor(s, 2); s += __shfl_xor(s, 4); s += __shfl_xor(s, 8);
                if ((lane & 15) == 0) { unsafeAtomicAdd(SSQ1 + PADR + mr, s); unsafeAtomicAdd(SSQ1 + LP + PADR + mr, s); } }
        }
    }
    SEAM(5);
    if (IN(6)) { phase6(C, lds, tid, lane, wave, bid, G, 0); if (REPK(6)) { xcd_barrier(xbar); phase6(C, lds, tid, lane, wave, bid, G, 1); } }
    SEAM(6);
    if (IN(7)) { phase7(C, lds, tid, lane, wave, bid, G, 0); if (REPK(7)) { xcd_barrier(xbar); phase7(C, lds, tid, lane, wave, bid, G, 1); } }
    SEAM(7);
    if (IN(8)) { for (;;) { const int t = block_fetch(CTR + 5, slot, tid); if (t >= 128) break; kvscan_wg<1>(C, t, lds, tid, lane, wave); } if (REPK(8)) { xcd_barrier(xbar); for (;;) { const int t = block_fetch(CTR + 13, slot, tid); if (t >= 128) break; kvscan_wg<1>(C, t, lds, tid, lane, wave); } } }
    SEAM(8);
    if (IN(9)) { for (;;) { const int t = block_fetch(CTR + 6, slot, tid); if (t >= 8 * 32) break; mixout_wg<1>(C, t, lds, tid, lane, wave); } if (REPK(9)) { xcd_barrier(xbar); for (;;) { const int t = block_fetch(CTR + 14, slot, tid); if (t >= 8 * 32) break; mixout_wg<1>(C, t, lds, tid, lane, wave); } } }
    SEAM(9);
    if (IN(10)) {
        pg8::Gemm g{Y1, WO2T, 2048, 2048, 2048}; pg8::StaticOrder S; S.init(8192, 2048, G, bid);
        pg8::EpiOut<1> E{C};
        pg8::gemm_phase(lds, g, S, E);
    }
    SEAM(10);
#ifdef EXTRA_SYNCS
    for (int q = 0; q < EXTRA_SYNCS; ++q) grid.sync();
#endif
    if (IN(11)) {
        for (int r = gw; r < 8192; r += NGW) {
            const float rstd = rsqrtf(SSQ2[r] * (1.f / 2048.f) + EPS);
            float* row = C.out + (size_t)r * DM;
#pragma unroll
            for (int j = 0; j < 8; ++j) { const int c = (lane + 64 * j) * 4; const f32x4 v = *(const f32x4*)(row + c), w = *(const f32x4*)(C.final_w + c); *(f32x4*)(row + c) = v * rstd * w; }
        }
    }
#ifdef PROBE_A
    grid.sync();
    if (bid == 0) {
        if (tid == 0) STAMP[12] = __builtin_amdgcn_s_memrealtime();
        __syncthreads();
        const float da = (float)(STAMP[PROBE_A + 1] - STAMP[PROBE_A]) * 0.01f, db = (float)(STAMP[PROBE_B + 1] - STAMP[PROBE_B]) * 0.01f;
        if (tid == 0) C.out[0] = da;
        for (int i = 1048576 + tid; i < 2097152; i += 512) C.out[i] += db * 0.01f;
    }
#endif
#undef IN
#undef SEAM
}

__global__ void dump_k(const bf16_t* src, float* out, int n) { for (int i = blockIdx.x * blockDim.x + threadIdx.x; i < n; i += gridDim.x * blockDim.x) { if (i < 8650752) { const int row = i / 2048; out[i] = (row >= 128 && row < 4096) ? bf2f(src[(size_t)row * 3072 + (i % 2048)]) : 0.f; } } }
extern "C" void kernel_launch(void* const* d_in, const int* in_sizes, int n_in, void* d_out, int out_size, void* d_ws, size_t ws_size, hipStream_t stream) {
    static int ready = 0;
    if (!ready) {
        if (hipFuncSetAttribute((const void*)fwd, hipFuncAttributeMaxDynamicSharedMemorySize, LDS_BYTES) != hipSuccess) fprintf(stderr, "kernel_launch: hipFuncSetAttribute failed\n");
        ready = 1;
    }
    Ctx c{};
    const float** p = (const float**)&c;
    for (int i = 0; i < 22; ++i) p[i] = (const float*)d_in[i];
    c.out = (float*)d_out; c.ws = (unsigned char*)d_ws;
#ifdef MK_MULTI
    hipMemsetAsync(d_ws, 0, 268435456, stream); hipMemsetAsync(d_out, 0, (size_t)out_size * 4, stream);
    for (int ph = 0; ph < RUN_PH; ++ph) { c.ph_lo = ph; c.ph_hi = ph + 1; hipLaunchKernelGGL(fwd, dim3(256), dim3(512), LDS_BYTES, stream, c); }
#ifdef DUMP_SLOT
    hipLaunchKernelGGL(dump_k, dim3(2048), dim3(256), 0, stream, (const bf16_t*)((unsigned char*)d_ws + (size_t)DUMP_SLOT * SLOT), (float*)d_out, out_size);
#endif
#else
    c.ph_lo = 0; c.ph_hi = NPHASE;
    (void)hipMemsetAsync((unsigned char*)d_ws + MISC + M_BAR, 0, 16384, stream);
    void* args[] = {&c};
    hipError_t e = hipLaunchCooperativeKernel((const void*)fwd, dim3(256), dim3(512), args, LDS_BYTES, stream);
    if (e != hipSuccess) fprintf(stderr, "cooperative launch failed: %s\n", hipGetErrorString(e));
#endif
}
```
